# Optimizing an MI355X kernel written in HIP

```python
import functools
import jax
import jax.numpy as jnp
from jax import lax
import numpy as np

D_MODEL = 1024
BATCH = 1
SEQ = 16384
DEPTH = 1
DEC_BATCH = 128
DEC_SEQ = 8
PAST_LEN = 8192
PAGE_SIZE = 128

ATT_HEAD_DIM = 64
ATT_WIDTH = D_MODEL // 2
ATT_HEADS = ATT_WIDTH // ATT_HEAD_DIM
ROT_DIM = ATT_HEAD_DIM // 4
ROPE_THETA = 500000.0
DILATED_BRANCHES = ((128, 1), (512, 4), (2048, 16))
WINDOW_MAX = 2048
ATT_BLOCK = 128
MLSTM_WIDTH = D_MODEL - ATT_WIDTH
MLSTM_HEADS = 4
MLSTM_HEAD_DIM = MLSTM_WIDTH // MLSTM_HEADS
MLSTM_CHUNK = 128
FORGET_BIAS = 3.0
MIX_WIDTH = ATT_WIDTH + MLSTM_WIDTH
IN_COLS = 3 * ATT_WIDTH + 4 * MLSTM_WIDTH + 2 * MLSTM_HEADS
PEER_HEADS = 8
PEER_NKEYS = 128
PEER_EXPERTS = PEER_NKEYS * PEER_NKEYS
PEER_QDIM = 256
PEER_HALF = PEER_QDIM // 2
PEER_TOPK = 16
PEER_BLOCK = 256
EPS = 1e-6

kernel_name = 'hymba_dilated_mlstm_peer_adaln_step'


def rmsnorm(x, g):
    xf = x.astype(jnp.float32)
    y = xf * lax.rsqrt(jnp.mean(xf * xf, axis=-1, keepdims=True) + EPS)
    return (y * g.astype(jnp.float32)).astype(x.dtype)


def ada_modulation(c, w_ada, b_ada):
    mod = jax.nn.silu(c) @ w_ada + b_ada
    return [m[:, None, :] for m in jnp.split(mod, 6, axis=-1)]


def rope(x, pos):
    half = ROT_DIM // 2
    inv_freq = ROPE_THETA ** (-(jnp.arange(half, dtype=jnp.float32) * 2.0 / ROT_DIM))
    ang = pos.astype(jnp.float32)[:, None] * inv_freq[None, :]
    cos = jnp.cos(ang)[None, :, None, :]
    sin = jnp.sin(ang)[None, :, None, :]
    xr = x[..., :ROT_DIM].astype(jnp.float32)
    x1, x2 = xr[..., :half], xr[..., half:]
    rot = jnp.concatenate([x1 * cos - x2 * sin, x1 * sin + x2 * cos], axis=-1)
    return jnp.concatenate([rot.astype(x.dtype), x[..., ROT_DIM:]], axis=-1)


def dilated_branch_prompt(q, k, v, window, dil):
    B, S, H, Dh = q.shape
    nk = window // dil
    unit = dil * ATT_BLOCK
    Sp = -(-S // unit) * unit
    M = Sp // dil
    nb = M // ATT_BLOCK

    def split(a):
        a = jnp.pad(a, ((0, 0), (0, Sp - S), (0, 0), (0, 0)))
        a = a.reshape(B, M, dil, H, Dh).transpose(0, 2, 1, 3, 4)
        return a.reshape(B, dil, nb, ATT_BLOCK, H, Dh)

    def with_prev(a):
        prev = jnp.pad(a, ((0, 0), (0, 0), (1, 0), (0, 0), (0, 0), (0, 0)))[:, :, :-1]
        return jnp.concatenate([prev, a], axis=3)

    qb = split(q)
    kc = with_prev(split(k))
    vc = with_prev(split(v))
    s = jnp.einsum('brnqhd,brnkhd->brnhqk', qb, kc,
                   preferred_element_type=jnp.float32) * (ATT_HEAD_DIM ** -0.5)
    i = jnp.arange(ATT_BLOCK)[:, None]
    j = jnp.arange(2 * ATT_BLOCK)[None, :]
    dist = ATT_BLOCK + i - j
    blk = jnp.arange(nb)[:, None, None]
    valid = (dist >= 0) & (dist <= nk) & (blk * ATT_BLOCK + j - ATT_BLOCK >= 0)
    s = jnp.where(valid[None, None, :, None], s, -jnp.inf)
    m = jnp.max(s, axis=-1)
    p = jnp.exp(s - m[..., None])
    l = jnp.sum(p, axis=-1)
    o = jnp.einsum('brnhqk,brnkhd->brnqhd', p, vc.astype(jnp.float32))
    o = o / jnp.swapaxes(l, -1, -2)[..., None]
    lse = jnp.swapaxes(m + jnp.log(l), -1, -2)
    o = o.reshape(B, dil, M, H, Dh).transpose(0, 2, 1, 3, 4).reshape(B, Sp, H, Dh)[:, :S]
    lse = lse.reshape(B, dil, M, H).transpose(0, 2, 1, 3).reshape(B, Sp, H)[:, :S]
    return o, lse


def dilated_branch_sample(q, kall, vall, window, dil, wb):
    T = q.shape[1]
    nk = window // dil
    idx = wb + jnp.arange(T)[:, None] - dil * jnp.arange(nk + 1)[None, :]
    valid = idx >= 0
    idxc = jnp.clip(idx, 0)
    kg = kall[:, idxc]
    vg = vall[:, idxc]
    s = jnp.einsum('bthd,btjhd->bthj', q, kg,
                   preferred_element_type=jnp.float32) * (ATT_HEAD_DIM ** -0.5)
    s = jnp.where(valid[None, :, None, :], s, -jnp.inf)
    m = jnp.max(s, axis=-1)
    p = jnp.exp(s - m[..., None])
    l = jnp.sum(p, axis=-1)
    o = jnp.einsum('bthj,btjhd->bthd', p, vg.astype(jnp.float32)) / l[..., None]
    return o, m + jnp.log(l)


def combine_branches(outs, lses):
    w = jax.nn.softmax(jnp.stack(lses, axis=0), axis=0)
    return jnp.einsum('nbsh,nbshd->bshd', w, jnp.stack(outs, axis=0))


def att_prompt(q, k, v):
    outs, lses = [], []
    for window, dil in DILATED_BRANCHES:
        o, lse = dilated_branch_prompt(q, k, v, window, dil)
        outs.append(o)
        lses.append(lse)
    keep = min(WINDOW_MAX, q.shape[1])
    return combine_branches(outs, lses), (k[:, -keep:], v[:, -keep:])


def att_sample(q, k, v, k_buf, v_buf):
    wb = k_buf.shape[1]
    kall = jnp.concatenate([k_buf.astype(k.dtype), k], axis=1)
    vall = jnp.concatenate([v_buf.astype(v.dtype), v], axis=1)
    outs, lses = [], []
    for window, dil in DILATED_BRANCHES:
        o, lse = dilated_branch_sample(q, kall, vall, window, dil, wb)
        outs.append(o)
        lses.append(lse)
    return combine_branches(outs, lses), (k, v)


def mlstm_chunk(carry, inp):
    C, n, m = carry
    q, k, v, ig, lf = inp
    L = q.shape[2]
    F = jnp.cumsum(lf, axis=-1)
    causal = jnp.tril(jnp.ones((L, L), dtype=bool))
    logD = jnp.where(causal, F[..., :, None] - F[..., None, :] + ig[..., None, :], -jnp.inf)
    inter = F + m[..., None]
    m_t = jnp.maximum(jnp.max(logD, axis=-1), inter)
    Dm = jnp.exp(logD - m_t[..., None])
    a_inter = jnp.exp(inter - m_t)
    qk = jnp.einsum('bhtd,bhsd->bhts', q, k) * Dm
    num = jnp.einsum('bhts,bhsd->bhtd', qk, v) + a_inter[..., None] * jnp.einsum('bhvk,bhtk->bhtv', C, q)
    den = jnp.sum(qk, axis=-1) + a_inter * jnp.einsum('bhk,bhtk->bht', n, q)
    h = num / jnp.maximum(jnp.abs(den), jnp.exp(-m_t))[..., None]
    m_new = m_t[..., -1]
    w_s = jnp.exp(F[..., -1:] - F + ig - m_new[..., None])
    decay = jnp.exp(F[..., -1] + m - m_new)
    C_new = decay[..., None, None] * C + jnp.einsum('bhs,bhsv,bhsk->bhvk', w_s, v, k)
    n_new = decay[..., None] * n + jnp.einsum('bhs,bhsk->bhk', w_s, k)
    return (C_new, n_new, m_new), h


def mlstm_run(q, k, v, ig, lf, C0, n0, m0, chunk):
    B, S, H, Dh = q.shape
    nc = S // chunk

    def to_chunks(a):
        return a.reshape(B, nc, chunk, H, -1).transpose(1, 0, 3, 2, 4)

    xs = (to_chunks(q), to_chunks(k), to_chunks(v),
          to_chunks(ig[..., None])[..., 0], to_chunks(lf[..., None])[..., 0])
    (C, n, m), h = lax.scan(mlstm_chunk, (C0, n0, m0), xs)
    h = h.transpose(1, 0, 3, 2, 4).reshape(B, S, H, Dh)
    return h, (C, n, m)


def mlstm_prompt(q, k, v, ig, lf):
    B, S, H, Dh = q.shape
    C0 = jnp.zeros((B, H, Dh, Dh), jnp.float32)
    n0 = jnp.zeros((B, H, Dh), jnp.float32)
    m0 = jnp.zeros((B, H), jnp.float32)
    return mlstm_run(q, k, v, ig, lf, C0, n0, m0, min(MLSTM_CHUNK, S))


def mlstm_sample(q, k, v, ig, lf, C0, n0, m0):
    return mlstm_run(q, k, v, ig, lf, C0.astype(jnp.float32), n0.astype(jnp.float32),
                     m0.astype(jnp.float32), q.shape[1])


def peer_ffn(h, w_pq, keys_a, keys_b, peer_u, peer_v):
    T, D = h.shape
    Tp = -(-T // PEER_BLOCK) * PEER_BLOCK
    hp = jnp.pad(h, ((0, Tp - T), (0, 0))).reshape(Tp // PEER_BLOCK, PEER_BLOCK, D)

    def block(xb):
        q = (xb @ w_pq).reshape(PEER_BLOCK, PEER_HEADS, PEER_QDIM)
        sa = jnp.einsum('thd,hnd->thn', q[..., :PEER_HALF], keys_a, preferred_element_type=jnp.float32)
        sb = jnp.einsum('thd,hnd->thn', q[..., PEER_HALF:], keys_b, preferred_element_type=jnp.float32)
        va, ia = lax.top_k(sa, PEER_TOPK)
        vb, ib = lax.top_k(sb, PEER_TOPK)
        cand = (va[..., :, None] + vb[..., None, :]).reshape(PEER_BLOCK, PEER_HEADS, PEER_TOPK * PEER_TOPK)
        sc, ic = lax.top_k(cand, PEER_TOPK)
        ea = jnp.take_along_axis(ia, ic // PEER_TOPK, axis=-1)
        eb = jnp.take_along_axis(ib, ic % PEER_TOPK, axis=-1)
        e = ea * PEER_NKEYS + eb
        g = jax.nn.softmax(sc, axis=-1)
        act = jax.nn.gelu(jnp.einsum('thkd,td->thk', peer_u[e], xb,
                                     preferred_element_type=jnp.float32), approximate=False)
        coef = (g * act).astype(xb.dtype)
        return jnp.einsum('thk,thkd->td', coef, peer_v[e])

    return lax.map(block, hp).reshape(Tp, D)[:T]


def decoder_layer(x, c, pos, att_fn, mlstm_fn, w_ada, b_ada, g_mix, w_in, b_gates, g_grp,
                  w_out, g_ffn, w_pq, keys_a, keys_b, peer_u, peer_v):
    B, S, D = x.shape
    sh_a, sc_a, gt_a, sh_f, sc_f, gt_f = ada_modulation(c, w_ada, b_ada)
    h = rmsnorm(x, g_mix) * (1 + sc_a) + sh_a
    proj = h @ w_in
    A, M, H = ATT_WIDTH, MLSTM_WIDTH, MLSTM_HEADS
    cuts = [int(t) for t in np.cumsum([A, A, A, M, M, M, M, H])]
    aq, ak, av, mq, mk, mv, mo, mi, mf = jnp.split(proj, cuts, axis=-1)
    aq = rope(aq.reshape(B, S, ATT_HEADS, ATT_HEAD_DIM), pos)
    ak = rope(ak.reshape(B, S, ATT_HEADS, ATT_HEAD_DIM), pos)
    av = av.reshape(B, S, ATT_HEADS, ATT_HEAD_DIM)
    att, att_state = att_fn(aq, ak, av)
    f32 = jnp.float32
    ig = mi.astype(f32) + b_gates[:H].astype(f32)
    lf = jax.nn.log_sigmoid(mf.astype(f32) + b_gates[H:].astype(f32))
    mq = mq.reshape(B, S, H, MLSTM_HEAD_DIM).astype(f32)
    mk = mk.reshape(B, S, H, MLSTM_HEAD_DIM).astype(f32) * (MLSTM_HEAD_DIM ** -0.5)
    mv = mv.reshape(B, S, H, MLSTM_HEAD_DIM).astype(f32)
    hm, mlstm_state = mlstm_fn(mq, mk, mv, ig, lf)
    hm = hm.reshape(B, S, M) * jax.nn.sigmoid(mo.astype(f32))
    mixed = jnp.concatenate([rmsnorm(att.reshape(B, S, A).astype(x.dtype), g_grp[:A]),
                             rmsnorm(hm.astype(x.dtype), g_grp[A:])], axis=-1)
    x = x + gt_a * (mixed @ w_out)
    h2 = rmsnorm(x, g_ffn) * (1 + sc_f) + sh_f
    y = peer_ffn(h2.reshape(B * S, D), w_pq, keys_a, keys_b, peer_u, peer_v).reshape(B, S, D)
    x = x + gt_f * y
    return x, att_state, mlstm_state


def setup_inputs(seed: int = 0) -> dict:
    key = jax.random.key(seed)
    ks = jax.random.split(key, 24)
    f32 = jnp.float32
    D = D_MODEL
    wb = min(WINDOW_MAX, PAST_LEN)

    def nrm(k, shape, s):
        return jax.random.normal(k, shape, f32) * s

    b_gates = jnp.concatenate([nrm(ks[12], (DEPTH, MLSTM_HEADS), 0.1),
                               FORGET_BIAS + nrm(ks[13], (DEPTH, MLSTM_HEADS), 0.1)], axis=-1)
    return {
        'x_prompt': nrm(ks[0], (BATCH, SEQ, D), 1.0),
        'x_sample': nrm(ks[1], (DEC_BATCH, DEC_SEQ, D), 1.0),
        'cache_k': nrm(ks[2], (DEPTH, DEC_BATCH, wb, ATT_HEADS, ATT_HEAD_DIM), 1.0),
        'cache_v': nrm(ks[3], (DEPTH, DEC_BATCH, wb, ATT_HEADS, ATT_HEAD_DIM), 1.0),
        'state_C': nrm(ks[4], (DEPTH, DEC_BATCH, MLSTM_HEADS, MLSTM_HEAD_DIM, MLSTM_HEAD_DIM), 0.1),
        'state_n': nrm(ks[5], (DEPTH, DEC_BATCH, MLSTM_HEADS, MLSTM_HEAD_DIM), 0.3),
        'state_m': jax.random.uniform(ks[6], (DEPTH, DEC_BATCH, MLSTM_HEADS), f32, 1.0, 3.0),
        'c_prompt': nrm(ks[7], (BATCH, D), 1.0),
        'c_sample': nrm(ks[8], (DEC_BATCH, D), 1.0),
        'w_ada': nrm(ks[9], (DEPTH, D, 6 * D), 0.5 * D ** -0.5),
        'b_ada': nrm(ks[10], (DEPTH, 6 * D), 0.1),
        'g_mix': 1.0 + nrm(ks[11], (DEPTH, D), 0.05),
        'w_in': nrm(ks[14], (DEPTH, D, IN_COLS), D ** -0.5),
        'b_gates': b_gates,
        'g_grp': 1.0 + nrm(ks[15], (DEPTH, MIX_WIDTH), 0.05),
        'w_out': nrm(ks[16], (DEPTH, MIX_WIDTH, D), MIX_WIDTH ** -0.5),
        'g_ffn': 1.0 + nrm(ks[17], (DEPTH, D), 0.05),
        'w_pq': nrm(ks[18], (DEPTH, D, PEER_HEADS * PEER_QDIM), D ** -0.5),
        'peer_keys_a': nrm(ks[19], (DEPTH, PEER_HEADS, PEER_NKEYS, PEER_HALF), PEER_HALF ** -0.5),
        'peer_keys_b': nrm(ks[20], (DEPTH, PEER_HEADS, PEER_NKEYS, PEER_HALF), PEER_HALF ** -0.5),
        'peer_u': nrm(ks[21], (DEPTH, PEER_EXPERTS, D), D ** -0.5),
        'peer_v': nrm(ks[22], (DEPTH, PEER_EXPERTS, D), (PEER_HEADS * PEER_TOPK) ** -0.5),
        'g_final': 1.0 + nrm(ks[23], (D,), 0.05),
    }


def reference(x_prompt, x_sample, cache_k, cache_v, state_C, state_n, state_m, c_prompt, c_sample,
              w_ada, b_ada, g_mix, w_in, b_gates, g_grp, w_out, g_ffn, w_pq,
              peer_keys_a, peer_keys_b, peer_u, peer_v, g_final):
    S = x_prompt.shape[1]
    T = x_sample.shape[1]
    pos_p = jnp.arange(S, dtype=jnp.int32)
    pos_s = PAST_LEN + jnp.arange(T, dtype=jnp.int32)
    xp, xs = x_prompt, x_sample
    kp, vp, ksm, vsm, Cp, nP, mP, Cs, nS, mS = [], [], [], [], [], [], [], [], [], []
    for l in range(DEPTH):
        w = (w_ada[l], b_ada[l], g_mix[l], w_in[l], b_gates[l], g_grp[l], w_out[l], g_ffn[l],
             w_pq[l], peer_keys_a[l], peer_keys_b[l], peer_u[l], peer_v[l])
        xp, (k1, v1), (C1, n1, m1) = decoder_layer(xp, c_prompt, pos_p, att_prompt, mlstm_prompt, *w)
        att_s = functools.partial(att_sample, k_buf=cache_k[l], v_buf=cache_v[l])
        mlstm_s = functools.partial(mlstm_sample, C0=state_C[l], n0=state_n[l], m0=state_m[l])
        xs, (k2, v2), (C2, n2, m2) = decoder_layer(xs, c_sample, pos_s, att_s, mlstm_s, *w)
        kp.append(k1); vp.append(v1); Cp.append(C1); nP.append(n1); mP.append(m1)
        ksm.append(k2); vsm.append(v2); Cs.append(C2); nS.append(n2); mS.append(m2)
    y_prompt = rmsnorm(xp, g_final)
    y_sample = rmsnorm(xs, g_final)
    return (y_prompt, y_sample, jnp.stack(kp), jnp.stack(vp), jnp.stack(ksm), jnp.stack(vsm),
            jnp.stack(Cp), jnp.stack(nP), jnp.stack(mP), jnp.stack(Cs), jnp.stack(nS), jnp.stack(mS))
```

```cpp
#include <hip/hip_runtime.h>
#include <cstdio>
#include <cstdint>
#include <cmath>
#ifndef MK_ONE_LAUNCH
#define MK_ONE_LAUNCH 1
#endif
#define LAS __attribute__((address_space(3)))
#define GAS __attribute__((address_space(1)))
typedef unsigned short bf16;
typedef short bf16x8 __attribute__((ext_vector_type(8)));
typedef float f32x4 __attribute__((ext_vector_type(4)));
typedef float f32x2 __attribute__((ext_vector_type(2)));
typedef unsigned u32x4 __attribute__((ext_vector_type(4)));
typedef unsigned u32x2 __attribute__((ext_vector_type(2)));

constexpr int NP = 16384, NSMP = 1024, MT = NP + NSMP, DM = 1024;
constexpr int NWAVES = 8, NTHREADS = 512, NPH = 11;
constexpr int P1W = 2560;
constexpr int C_AQ = 0, C_AK = 512, C_MQ = 1024, C_MO = 1536, C_MK = 2048;
constexpr int R_MVT = 0, R_AVT = 512;
constexpr size_t MiB = 1u << 20;
constexpr size_t WS_CTL = 0, CTL_ZERO_BYTES = 1 * MiB;
constexpr size_t WS_MOD = 1 * MiB, WS_ROPE = 5 * MiB, WS_IG = 7 * MiB, WS_LF = 8 * MiB, WS_BS = 9 * MiB, WS_CMB = 10 * MiB, WS_CH = 11 * MiB;
constexpr size_t WS_WIN = 12 * MiB, WS_WOUT = 20 * MiB, WS_WPQ = 22 * MiB, WS_KEYS = 26 * MiB, WS_U = 27 * MiB, WS_V = 59 * MiB;
constexpr size_t WS_H = 91 * MiB, WS_P1 = 125 * MiB, WS_PT = 210 * MiB, WS_VT4 = 261 * MiB, WS_VT16 = 277 * MiB, WS_ATT = 293 * MiB, WS_HMS = 310 * MiB;
constexpr size_t WS_MIX = 312 * MiB, WS_X1 = 346 * MiB, WS_QP = 414 * MiB, WS_DC = 482 * MiB, WS_DN = 514 * MiB, WS_CPREV = 515 * MiB, WS_NPREV = 531 * MiB, WS_SELE = 532 * MiB, WS_SELG = 541 * MiB, WS_HM = 550 * MiB, WS_SSA = 567 * MiB, WS_SSM = 568 * MiB, WS_END = 569 * MiB;
constexpr size_t O_YP = 0, O_YS = 16777216, O_KP = 17825792, O_VP = 18874368, O_KS = 19922944, O_VS = 20447232, O_CP = 20971520, O_NP = 21037056, O_MP = 21037568,
                 O_CS = 21037572, O_NS = 29426180, O_MS = 29491716, O_END = 29492228;
constexpr int CW_BAR = 4096;
constexpr int RING_BYTES = 131072, LDS_BYTES = 147456, LDSCTL_OFF = LDS_BYTES - 1024;
constexpr float EPS = 1e-6f;

struct Args { const float* in[23]; float* out; unsigned char* ws; int ph_lo, ph_hi; };

__device__ __forceinline__ unsigned f2bf(float f) { unsigned u = __builtin_bit_cast(unsigned, f); return (u + 0x7fffu + ((u >> 16) & 1u)) >> 16; }
__device__ __forceinline__ unsigned pk2(float lo, float hi) { return f2bf(lo) | (f2bf(hi) << 16); }
__device__ __forceinline__ float bf_lo(unsigned w) { return __uint_as_float(w << 16); }
__device__ __forceinline__ float bf_hi(unsigned w) { return __uint_as_float(w & 0xffff0000u); }
__device__ __forceinline__ float wave_sum(float v) {
#pragma unroll
    for (int o = 1; o < 64; o <<= 1) v += __shfl_xor(v, o);
    return v;
}
__device__ __forceinline__ f32x4 mfma16(bf16x8 a, bf16x8 b, f32x4 c) { return __builtin_amdgcn_mfma_f32_16x16x32_bf16(a, b, c, 0, 0, 0); }
__device__ __forceinline__ bf16x8 ldfrag(const bf16* p) { return *(const bf16x8*)p; }
__device__ __forceinline__ bf16x8 pack8(f32x4 a, f32x4 b) { u32x4 w; w.x = pk2(a[0], a[1]); w.y = pk2(a[2], a[3]); w.z = pk2(b[0], b[1]); w.w = pk2(b[2], b[3]); return __builtin_bit_cast(bf16x8, w); }
__device__ __forceinline__ float sigmoidf_(float x) { return __builtin_amdgcn_rcpf(1.f + __expf(-x)); }
#define LDS_WAIT() asm volatile("s_waitcnt lgkmcnt(0)" ::: "memory")
namespace pg8 {
#define PG8_LAS __attribute__((address_space(3)))
typedef unsigned short bf16_t;
typedef short bf16x8 __attribute__((ext_vector_type(8)));
typedef float f32x4 __attribute__((ext_vector_type(4)));
typedef unsigned u32x4 __attribute__((ext_vector_type(4)));
constexpr int BM = 256, BK = 64, HALF = 128, HTB = HALF * BK * 2  , STAGE_BYTES = 8 * HTB, NXCD = 8, WGM = 8;

__host__ __device__ __forceinline__ int lds_byte(int r, int c) { const int st = (r >> 4) * 2 + (c >> 5), rr = r & 15, cc = c & 31, ob = rr * 64 + cc * 2; return st * 1024 + (ob ^ (((ob >> 9) & 1) << 5)); }
__host__ __device__ __forceinline__ void stage_rc(int b, int& R, int& C) { const int st = b / 1024, sb = b % 1024, swz = sb ^ (((sb >> 9) & 1) << 5); R = (st >> 1) * 16 + swz / 64; C = (st & 1) * 32 + (swz % 64) / 2; }
__host__ __device__ __forceinline__ int perm32(int rho) { const int n = rho >> 4, i = rho & 15; return 8 * (i >> 2) + 4 * n + (i & 3); }

struct Unit { int pm, pn, half; };
struct Gemm { const bf16_t* A; const bf16_t* Bt; int M, N, K; const bf16_t* A2; const bf16_t* Bt2; };

struct StaticOrder {
    int nM, nN, nwg, G, c;
    __host__ __device__ void init(int M, int N, int G_, int c_) { nM = M / BM; nN = N / BM; nwg = nM * nN; G = G_; c = c_; }
    __host__ __device__ bool next(int i, Unit& u) const {
        const long L = (long)i * G + c; if (L >= nwg) return false;
        int wgid = (int)L; { const int q = nwg / NXCD, r = nwg % NXCD, xcd = wgid % NXCD, off = wgid / NXCD; wgid = (xcd < r ? xcd * (q + 1) : r * (q + 1) + (xcd - r) * q) + off; }
        const int nig = WGM * nN, gid = wgid / nig, fm = gid * WGM, gsz = (nM - fm) < WGM ? (nM - fm) : WGM;
        u.pm = fm + ((wgid % nig) % gsz); u.pn = (wgid % nig) / gsz; return true;
    }
    __device__ __forceinline__ void a_ready(const Unit&) const {}
    __device__ __forceinline__ void done(const Unit&) const {}
};
struct PairOrder {
    StaticOrder S;
    __host__ __device__ bool next(int i, Unit& u) const { if (!S.next(i >> 1, u)) return false; u.half = i & 1; return true; }
    __device__ __forceinline__ void a_ready(const Unit&) const {}
    __device__ __forceinline__ void done(const Unit&) const {}
};

__device__ __forceinline__ unsigned cvt_pk_bf16(float lo, float hi) { unsigned r; asm volatile("v_cvt_pk_bf16_f32 %0, %1, %2" : "=v"(r) : "v"(lo), "v"(hi)); return r; }
typedef float f32x2 __attribute__((ext_vector_type(2)));
__device__ __forceinline__ f32x2 gelu_pk(f32x2 v) {
    const f32x2 av = __builtin_elementwise_abs(v), d = av * 0.2316418882f + 1.0f;
    f32x2 t; t.x = __builtin_amdgcn_rcpf(d.x); t.y = __builtin_amdgcn_rcpf(d.y);
    f32x2 q = t * 0.5307027145f + (-0.7265760135f); q = q * t + 0.7107068705f; q = q * t + (-0.142248368f); q = q * t + 0.127414796f; q = q * t;
    const f32x2 s = (v * v) * (-0.72134752044f);
    f32x2 e; e.x = __builtin_amdgcn_exp2f(s.x); e.y = __builtin_amdgcn_exp2f(s.y);
    const f32x2 m = v * (q * e), r = v - m;
    f32x2 o; o.x = v.x < 0.f ? m.x : r.x; o.y = v.y < 0.f ? m.y : r.y; return o;
}

template <int ACT  > struct EpiBf16 {
    static constexpr bool PERM = true, AFTER_DRAIN = false, PAIR = false; static_assert(ACT == 0 || ACT == 1, "EpiBf16: ACT is 0 (none) or 1 (gelu_pk)");
    bf16_t* O; int ldc; const float* bias; int split_cols; size_t split_stride; float scale0;
    __device__ __forceinline__ void operator()(const f32x4 (&acc)[2][2][4][2], const Unit& u, int wr, int wc, int fr, int fq) const {
        const int row0 = u.pm * BM + wr * 64 + fr; int colt = u.pn * BM; bf16_t* base = O;
        float sc = 1.f; if (split_cols) { const int t = colt / split_cols; base += (size_t)t * split_stride; colt -= t * split_cols; if (t == 0) sc = scale0; }
        const int col0 = colt + wc * 32 + 8 * fq, bcol0 = u.pn * BM + wc * 32 + 8 * fq;
        f32x4 bv[2][2];
#pragma unroll
        for (int bj = 0; bj < 2; ++bj)
#pragma unroll
            for (int n = 0; n < 2; ++n) bv[bj][n] = bias ? *(const f32x4*)(bias + bcol0 + bj * HALF + 4 * n) : (f32x4){0.f, 0.f, 0.f, 0.f};
#pragma unroll
        for (int ai = 0; ai < 2; ++ai)
#pragma unroll
            for (int m = 0; m < 4; ++m) { bf16_t* rowp = base + (size_t)(row0 + ai * HALF + m * 16) * ldc + col0;
#pragma unroll
                for (int bj = 0; bj < 2; ++bj) { f32x4 v0 = acc[ai][bj][m][0] + bv[bj][0], v1 = acc[ai][bj][m][1] + bv[bj][1];
                    if (ACT == 1) { f32x2 a = gelu_pk((f32x2){v0[0], v0[1]}), b = gelu_pk((f32x2){v0[2], v0[3]}), c = gelu_pk((f32x2){v1[0], v1[1]}), d = gelu_pk((f32x2){v1[2], v1[3]});
                        v0 = (f32x4){a.x, a.y, b.x, b.y}; v1 = (f32x4){c.x, c.y, d.x, d.y}; }
                    v0 = v0 * sc; v1 = v1 * sc; u32x4 w; w.x = cvt_pk_bf16(v0[0], v0[1]); w.y = cvt_pk_bf16(v0[2], v0[3]); w.z = cvt_pk_bf16(v1[0], v1[1]); w.w = cvt_pk_bf16(v1[2], v1[3]);
                    *(u32x4*)(rowp + bj * HALF) = w; } }
    }
};
template <class Epi, class Sched, bool ALIGN_EPI = false, bool SP2 = false>
__device__ __forceinline__ void gemm_phase(PG8_LAS unsigned char* lds, const Gemm g, const Sched& S, const Epi& E) {
    const int tid = threadIdx.x, wid = __builtin_amdgcn_readfirstlane(tid >> 6), lane = tid & 63, wr = wid >> 2, wc = wid & 3, fr = lane & 15, fq = lane >> 4;
    const int K = g.K, nt = K / BK;
    unsigned voffA[2], voffB[2];
#pragma unroll
    for (int i = 0; i < 2; ++i) { int R, C; stage_rc(tid * 16 + i * 8192, R, C); const int Rb = Epi::PERM ? ((R & ~31) + perm32(R & 31)) : R;
        voffA[i] = (unsigned)(R * K + C) * 2u; voffB[i] = (unsigned)(Rb * K + C) * 2u; }
    const size_t kstep = (size_t)(BK * 2);
    const size_t hstep = (size_t)HALF * K * 2;
    const size_t tstep = 2 * hstep;
    const unsigned ldsw = (unsigned)wid * 1024u;
    const int aoff = lds_byte(wr * 64 + fr, fq * 8), boff = lds_byte(wc * 32 + fr, fq * 8);
#define PG8_SA(b, h) (((b) * 2 + (h)) * HTB)
#define PG8_SB(b, h) ((4 + (b) * 2 + (h)) * HTB)
#define PG8_STAGE(bufoff, gbase, voff) do { _Pragma("unroll") for (int _i = 0; _i < 2; ++_i) \
        __builtin_amdgcn_global_load_lds((const unsigned*)((const char*)(gbase) + (voff)[_i]), (PG8_LAS unsigned*)(lds + (bufoff) + ldsw + _i * 8192), 16, 0, 0); } while (0)
#define PG8_LDA(dst, b, h) do { _Pragma("unroll") for (int m = 0; m < 4; ++m) _Pragma("unroll") for (int k = 0; k < 2; ++k) dst[m][k] = *(const PG8_LAS bf16x8*)(lds + PG8_SA(b, h) + aoff + m * 2048 + k * 1024); } while (0)
#define PG8_LDB(dst, b, h) do { _Pragma("unroll") for (int n = 0; n < 2; ++n) _Pragma("unroll") for (int k = 0; k < 2; ++k) dst[n][k] = *(const PG8_LAS bf16x8*)(lds + PG8_SB(b, h) + boff + n * 2048 + k * 1024); } while (0)
#define PG8_MMA(ai, bj, At, Bt) do { __builtin_amdgcn_s_setprio(1); _Pragma("unroll") for (int m = 0; m < 4; ++m) _Pragma("unroll") for (int n = 0; n < 2; ++n) _Pragma("unroll") for (int k = 0; k < 2; ++k) \
        acc[ai][bj][m][n] = __builtin_amdgcn_mfma_f32_16x16x32_bf16(Bt[n][k], At[m][k], acc[ai][bj][m][n], 0, 0, 0); __builtin_amdgcn_s_setprio(0); } while (0)
#define PG8_WAIT_V(n) asm volatile("s_waitcnt vmcnt(" #n ")" ::: "memory")
#define PG8_WAIT_L(n) asm volatile("s_waitcnt lgkmcnt(" #n ")" ::: "memory")
#define PG8_BAR __builtin_amdgcn_s_barrier()
#define PG8_SCHED __builtin_amdgcn_sched_barrier(0)
    Unit cur, nxt; int ui = 0;
    if (!S.next(0, cur)) return;
    f32x4 acc[2][2][4][2];
#pragma unroll
    for (int a = 0; a < 2; ++a)
#pragma unroll
        for (int b = 0; b < 2; ++b)
#pragma unroll
            for (int m = 0; m < 4; ++m)
#pragma unroll
                for (int n = 0; n < 2; ++n) acc[a][b][m][n] = (f32x4){0.f, 0.f, 0.f, 0.f};
    bf16x8 At[4][2], B0[2][2], B1[2][2];
    const char* cA; const char* cB;
    if constexpr (Epi::PAIR) { cA = (const char*)(cur.half ? g.A2 : g.A) + (size_t)cur.pm * tstep; cB = (const char*)(cur.half ? g.Bt2 : g.Bt) + (size_t)cur.pn * tstep; }
    else { cA = (const char*)g.A + (size_t)cur.pm * tstep; cB = (const char*)g.Bt + (size_t)cur.pn * tstep; }
    S.a_ready(cur);
    if constexpr (SP2) {
        PG8_STAGE(PG8_SB(0, 0), cB, voffB); PG8_STAGE(PG8_SB(0, 1), cB + hstep, voffB); PG8_STAGE(PG8_SA(0, 0), cA, voffA); PG8_STAGE(PG8_SA(0, 1), cA + hstep, voffA);
        if (wr == 1) PG8_BAR;
        PG8_WAIT_V(2); PG8_BAR;
        PG8_STAGE(PG8_SB(1, 0), cB + kstep, voffB); PG8_STAGE(PG8_SA(1, 0), cA + kstep, voffA); PG8_STAGE(PG8_SB(1, 1), cB + hstep + kstep, voffB);
        PG8_WAIT_V(6); PG8_BAR;
    } else {
        PG8_STAGE(PG8_SB(0, 0), cB, voffB); PG8_STAGE(PG8_SA(0, 0), cA, voffA); PG8_STAGE(PG8_SB(0, 1), cB + hstep, voffB); PG8_STAGE(PG8_SA(0, 1), cA + hstep, voffA);
        if (wr == 1) PG8_BAR;
        PG8_WAIT_V(4); PG8_BAR;
        PG8_STAGE(PG8_SB(1, 0), cB + kstep, voffB); PG8_STAGE(PG8_SA(1, 0), cA + kstep, voffA); PG8_STAGE(PG8_SB(1, 1), cB + hstep + kstep, voffB);
        PG8_WAIT_V(6); PG8_BAR;
    }
    for (;;) {
        const bool has_next = S.next(ui + 1, nxt);
        const char* nA; const char* nB;
        if constexpr (Epi::PAIR) { nA = has_next ? (const char*)(nxt.half ? g.A2 : g.A) + (size_t)nxt.pm * tstep : cA; nB = has_next ? (const char*)(nxt.half ? g.Bt2 : g.Bt) + (size_t)nxt.pn * tstep : cB; }
        else { nA = has_next ? (const char*)g.A + (size_t)nxt.pm * tstep : cA; nB = has_next ? (const char*)g.Bt + (size_t)nxt.pn * tstep : cB; }
        for (int t = 0; t < nt; t += 2) {
            const bool last = (t == nt - 2);
            const char* a1 = cA + (size_t)(t + 1) * kstep;
            const char* a2 = last ? nA : cA + (size_t)(t + 2) * kstep; const char* b2 = last ? nB : cB + (size_t)(t + 2) * kstep;
            const char* a3 = a2 + kstep; const char* b3 = b2 + kstep;
            if (last && has_next) S.a_ready(nxt);
            if constexpr (SP2) {
            PG8_LDB(B0, 0, 0); PG8_LDB(B1, 0, 1); PG8_SCHED; PG8_LDA(At, 0, 0); PG8_STAGE(PG8_SA(1, 1), a1 + hstep, voffA);
            PG8_WAIT_V(8); PG8_WAIT_L(0); PG8_BAR; PG8_MMA(0, 0, At, B0); PG8_MMA(0, 1, At, B1); PG8_BAR; PG8_SCHED;
            PG8_LDA(At, 0, 1); PG8_STAGE(PG8_SB(0, 0), b2, voffB); PG8_STAGE(PG8_SB(0, 1), b2 + hstep, voffB); PG8_STAGE(PG8_SA(0, 0), a2, voffA);
            PG8_WAIT_V(8); PG8_WAIT_L(0); PG8_BAR; PG8_MMA(1, 0, At, B0); PG8_MMA(1, 1, At, B1); PG8_BAR; PG8_SCHED;
            PG8_LDB(B0, 1, 0); PG8_LDB(B1, 1, 1); PG8_SCHED; PG8_LDA(At, 1, 0); PG8_STAGE(PG8_SA(0, 1), a2 + hstep, voffA);
            PG8_WAIT_V(8); PG8_WAIT_L(0); PG8_BAR; PG8_MMA(0, 0, At, B0); PG8_MMA(0, 1, At, B1); PG8_BAR; PG8_SCHED;
            PG8_LDA(At, 1, 1); PG8_STAGE(PG8_SB(1, 0), b3, voffB); PG8_STAGE(PG8_SB(1, 1), b3 + hstep, voffB); PG8_STAGE(PG8_SA(1, 0), a3, voffA);
            PG8_WAIT_V(8); PG8_WAIT_L(0); PG8_BAR; PG8_MMA(1, 0, At, B0); PG8_MMA(1, 1, At, B1); PG8_BAR; PG8_SCHED;
            } else {
            PG8_LDB(B0, 0, 0); PG8_SCHED; PG8_LDA(At, 0, 0); PG8_STAGE(PG8_SA(1, 1), a1 + hstep, voffA);
            PG8_WAIT_L(8); PG8_BAR; PG8_WAIT_L(0); PG8_MMA(0, 0, At, B0); PG8_BAR; PG8_SCHED;
            PG8_LDB(B1, 0, 1); PG8_STAGE(PG8_SB(0, 0), b2, voffB);
            PG8_BAR; PG8_WAIT_L(0); PG8_MMA(0, 1, At, B1); PG8_BAR;
            PG8_LDA(At, 0, 1); PG8_STAGE(PG8_SA(0, 0), a2, voffA);
            PG8_BAR; PG8_WAIT_L(0); PG8_MMA(1, 0, At, B0); PG8_BAR; PG8_SCHED;
            PG8_STAGE(PG8_SB(0, 1), b2 + hstep, voffB);
            PG8_WAIT_V(6); PG8_BAR; PG8_MMA(1, 1, At, B1); PG8_BAR;
            PG8_LDB(B0, 1, 0); PG8_SCHED; PG8_LDA(At, 1, 0); PG8_STAGE(PG8_SA(0, 1), a2 + hstep, voffA);
            PG8_WAIT_L(8); PG8_BAR; PG8_WAIT_L(0); PG8_MMA(0, 0, At, B0); PG8_BAR; PG8_SCHED;
            PG8_LDB(B1, 1, 1); PG8_STAGE(PG8_SB(1, 0), b3, voffB);
            PG8_BAR; PG8_WAIT_L(0); PG8_MMA(0, 1, At, B1); PG8_BAR;
            PG8_LDA(At, 1, 1); PG8_STAGE(PG8_SA(1, 0), a3, voffA);
            PG8_BAR; PG8_WAIT_L(0); PG8_MMA(1, 0, At, B0); PG8_BAR; PG8_SCHED;
            PG8_STAGE(PG8_SB(1, 1), b3 + hstep, voffB);
            PG8_WAIT_V(6); PG8_BAR; PG8_MMA(1, 1, At, B1); PG8_BAR;
            }
        }
        if constexpr (ALIGN_EPI) { if (wr == 0) PG8_BAR; }
        if constexpr (Epi::PAIR) { if (cur.half == 0) E.mid(acc, cur, wr, wc, fr, fq); else E(acc, cur, wr, wc, fr, fq); }
        else if constexpr (!Epi::AFTER_DRAIN) { E(acc, cur, wr, wc, fr, fq); S.done(cur); }
        if (!has_next) break;
        if (!(Epi::PAIR && cur.half == 0))
#pragma unroll
        for (int a = 0; a < 2; ++a)
#pragma unroll
            for (int b = 0; b < 2; ++b)
#pragma unroll
                for (int m = 0; m < 4; ++m)
#pragma unroll
                    for (int n = 0; n < 2; ++n) acc[a][b][m][n] = (f32x4){0.f, 0.f, 0.f, 0.f};
        cur = nxt; cA = nA; cB = nB; ++ui;
        if constexpr (ALIGN_EPI) { if (wr == 1) PG8_BAR; }
    }
    PG8_WAIT_V(0);
    if constexpr (!ALIGN_EPI) { if (wr == 0) PG8_BAR; }
    PG8_BAR;
    if constexpr (Epi::AFTER_DRAIN) { E.fused(acc, cur, wr, wc, fr, fq, lds, wid, lane); S.done(cur); }
#undef PG8_SA
#undef PG8_SB
#undef PG8_STAGE
#undef PG8_LDA
#undef PG8_LDB
#undef PG8_MMA
#undef PG8_WAIT_V
#undef PG8_WAIT_L
#undef PG8_BAR
#undef PG8_SCHED
}
}
typedef GAS unsigned gu32;
#define RLX_AGENT __ATOMIC_RELAXED, __HIP_MEMORY_SCOPE_AGENT
#define XB_TMO      128
#define XB_XCNT(j)  (256  + 64 * (j))
#define XB_XSUB(j)  (1280 + 64 * (j))
#define XB_XGEN(j)  (2304 + 64 * (j))
#define XB_TOP      3328
#define XB_TOPGEN   3392
#define XCD_BAR_WORDS 3456
#define XB_SPIN_CAP (1u << 18)

__device__ __forceinline__ unsigned xb_ld(unsigned* p)              { return __hip_atomic_load(p, __ATOMIC_RELAXED, __HIP_MEMORY_SCOPE_AGENT); }
__device__ __forceinline__ unsigned xb_add(unsigned* p, unsigned v) { return __hip_atomic_fetch_add(p, v, __ATOMIC_RELAXED, __HIP_MEMORY_SCOPE_AGENT); }
__device__ __forceinline__ unsigned xb_xcc_id() { return (unsigned)__builtin_amdgcn_s_getreg((3 << 11) | 20) & 0xFu; }
#define XB_SPIN(cond, bar) do { unsigned _sp = 0; while (cond) { __builtin_amdgcn_s_sleep(1); \
    if ((++_sp & 255u) == 0u) { if (xb_ld(&(bar)[XB_TMO])) break; if (_sp > XB_SPIN_CAP) { atomicAdd(&(bar)[XB_TMO], 1u); break; } } } } while (0)

struct XcdBarrier {
    unsigned* bar; unsigned x;
    volatile LAS unsigned* st;
};

__device__ __forceinline__ XcdBarrier xcd_barrier_post(unsigned* bar, volatile LAS unsigned* st) {
    XcdBarrier b; b.bar = bar; b.x = xb_xcc_id(); b.st = st;
    if (threadIdx.x == 0) (void)xb_add(&bar[XB_XCNT(b.x)], 1u);
    return b;
}
__device__ __forceinline__ void xcd_barrier_complete(unsigned* bar, unsigned x, unsigned& nloc, unsigned& nx) {
    const unsigned G = gridDim.x * gridDim.y * gridDim.z;
    unsigned sum, cnt, mine, sp = 0u;
    for (;;) {
        sum = 0u; cnt = 0u; mine = 0u;
#pragma unroll
        for (unsigned j = 0; j < 16; ++j) { const unsigned c = xb_ld(&bar[XB_XCNT(j)]); sum += c; cnt += (c > 0u) ? 1u : 0u; mine = (j == x) ? c : mine; }
        if (sum == G) break;
        __builtin_amdgcn_s_sleep(1);
        if ((++sp & 255u) == 0u) { if (xb_ld(&bar[XB_TMO])) break; if (sp > XB_SPIN_CAP) { atomicAdd(&bar[XB_TMO], 1u); break; } }
    }
    nloc = mine > 0u ? mine : 1u; nx = cnt > 0u ? cnt : 1u;
}

__device__ __forceinline__ void xcd_barrier(const XcdBarrier& b) {
    asm volatile("s_waitcnt vmcnt(0)" ::: "memory");
    __syncthreads();
    if (threadIdx.x == 0) {
        unsigned* bar = b.bar;
        __builtin_amdgcn_s_waitcnt(0);
        unsigned nloc = b.st[0], nx = b.st[1];
        if (nloc == 0u) { xcd_barrier_complete(bar, b.x, nloc, nx); b.st[0] = nloc; b.st[1] = nx; }
        const unsigned old = xb_add(&bar[XB_XSUB(b.x)], 1u);
        const unsigned gen = old / nloc;
        if (old + 1u == (gen + 1u) * nloc) {
            __builtin_amdgcn_fence(__ATOMIC_RELEASE, "agent");
            asm volatile("s_waitcnt vmcnt(0)" ::: "memory");
            const unsigned og = xb_add(&bar[XB_TOP], 1u);
            const unsigned tg = og / nx;
            if (og + 1u == (tg + 1u) * nx) xb_add(&bar[XB_TOPGEN], 1u);
            else XB_SPIN(xb_ld(&bar[XB_TOPGEN]) == tg, bar);
            __builtin_amdgcn_fence(__ATOMIC_ACQUIRE, "agent");
            xb_add(&bar[XB_XGEN(b.x)], 1u);
            asm volatile("s_waitcnt vmcnt(0)" ::: "memory");
        } else {
            XB_SPIN(xb_ld(&bar[XB_XGEN(b.x)]) == gen, bar);
            __builtin_amdgcn_fence(__ATOMIC_ACQUIRE, "agent");
            asm volatile("s_waitcnt vmcnt(0)" ::: "memory");
        }
    }
    __syncthreads();
}
struct EpiStd {
    static constexpr bool PERM = true, AFTER_DRAIN = false, PAIR = false;
    bf16* P1; const float* rope; float* kp; float* ks;
    __device__ __forceinline__ void operator()(const pg8::f32x4 (&acc)[2][2][4][2], const pg8::Unit& u, int wr, int wc, int fr, int fq) const {
        const int blk = u.pn >> 1;
        const bool do_rope = (blk <= 1) && ((wc & 1) == 0);
        const float scale = blk == 0 ? 0.125f : (blk == 4 ? 0.08838834764831845f : 1.f);
        const int row0 = u.pm * 256 + wr * 64 + fr, colw = u.pn * 256 + wc * 32 + 8 * fq;
#pragma unroll
        for (int ai = 0; ai < 2; ++ai)
#pragma unroll
            for (int m = 0; m < 4; ++m) {
                const int r = row0 + ai * 128 + m * 16;
                f32x4 cs0 = {1.f, 1.f, 1.f, 1.f}, cs1 = cs0, sn0 = {0.f, 0.f, 0.f, 0.f}, sn1 = sn0;
                if (do_rope) { const int pi = r < NP ? r : NP + ((r - NP) & 7); const f32x4* rp = (const f32x4*)(rope + (size_t)pi * 16); cs0 = rp[0]; cs1 = rp[1]; sn0 = rp[2]; sn1 = rp[3]; }
#pragma unroll
                for (int bj = 0; bj < 2; ++bj) {
                    f32x4 v0 = acc[ai][bj][m][0], v1 = acc[ai][bj][m][1];
                    if (do_rope) {
                        f32x4 p0, p1;
#pragma unroll
                        for (int e = 0; e < 4; ++e) { p0[e] = __shfl_xor(v0[e], 16); p1[e] = __shfl_xor(v1[e], 16); }
                        if (fq == 0) { v0 = v0 * cs0 - p0 * sn0; v1 = v1 * cs1 - p1 * sn1; }
                        else if (fq == 1) { v0 = p0 * sn0 + v0 * cs0; v1 = p1 * sn1 + v1 * cs1; }
                    }
                    v0 = v0 * scale; v1 = v1 * scale;
                    u32x4 w; w.x = pg8::cvt_pk_bf16(v0[0], v0[1]); w.y = pg8::cvt_pk_bf16(v0[2], v0[3]); w.z = pg8::cvt_pk_bf16(v1[0], v1[1]); w.w = pg8::cvt_pk_bf16(v1[2], v1[3]);
                    *(u32x4*)(P1 + (size_t)r * P1W + colw + bj * 128) = w;
                    if (blk == 1 && r >= NP - 2048) {
                        const int col = colw + bj * 128 - C_AK;
                        float* dst = (r < NP ? kp + (size_t)(r - (NP - 2048)) * 512 : ks + (size_t)(r - NP) * 512) + col;
                        *(f32x4*)dst = v0; *(f32x4*)(dst + 4) = v1;
                    }
                }
            }
    }
};
struct EpiTr {
    static constexpr bool PERM = true, AFTER_DRAIN = false, PAIR = false;
    bf16* PT; float* vp; float* vs;
    __device__ __forceinline__ void operator()(const pg8::f32x4 (&acc)[2][2][4][2], const pg8::Unit& u, int wr, int wc, int fr, int fq) const {
        const int blk = u.pm >> 1;
        const int f0 = u.pm * 256 + wr * 64 + fr, tok0 = u.pn * 256 + wc * 32 + 8 * fq;
        const bool vout = (blk == 1) && (u.pn >= (NP - 2048) / 256);
#pragma unroll
        for (int ai = 0; ai < 2; ++ai)
#pragma unroll
            for (int m = 0; m < 4; ++m) {
                const int f = f0 + ai * 128 + m * 16;
#pragma unroll
                for (int bj = 0; bj < 2; ++bj) {
                    const int tk = tok0 + bj * 128;
                    const f32x4 v0 = acc[ai][bj][m][0], v1 = acc[ai][bj][m][1];
                    u32x4 w; w.x = pg8::cvt_pk_bf16(v0[0], v0[1]); w.y = pg8::cvt_pk_bf16(v0[2], v0[3]); w.z = pg8::cvt_pk_bf16(v1[0], v1[1]); w.w = pg8::cvt_pk_bf16(v1[2], v1[3]);
                    *(u32x4*)(PT + (size_t)f * MT + tk) = w;
                    if (vout) {
                        const int vf = f - R_AVT;
                        float* dst = (tk < NP ? vp + (size_t)(tk - (NP - 2048)) * 512 : vs + (size_t)(tk - NP) * 512) + vf;
#pragma unroll
                        for (int e = 0; e < 4; ++e) { dst[(size_t)e * 512] = v0[e]; dst[(size_t)(e + 4) * 512] = v1[e]; }
                    }
                }
            }
    }
};
struct EpiX1P {
    static constexpr bool PERM = true, AFTER_DRAIN = false, PAIR = true;
    const float* xp; const float* xs; const float* mod; const float* SSA; const float* SSM; float* x1;
    __device__ __forceinline__ void mid(pg8::f32x4 (&acc)[2][2][4][2], const pg8::Unit& u, int wr, int wc, int fr, int fq) const {
        const int row0 = u.pm * 256 + wr * 64 + fr;
#pragma unroll
        for (int ai = 0; ai < 2; ++ai)
#pragma unroll
            for (int m = 0; m < 4; ++m) {
                const int r = row0 + ai * 128 + m * 16;
                const f32x4 a0 = *(const f32x4*)(SSA + (size_t)r * 8), a1 = *(const f32x4*)(SSA + (size_t)r * 8 + 4), m0 = *(const f32x4*)(SSM + (size_t)r * 4);
                const float ssa = ((a0[0] + a0[1]) + (a0[2] + a0[3])) + ((a1[0] + a1[1]) + (a1[2] + a1[3])), ssm = (m0[0] + m0[1]) + (m0[2] + m0[3]);
                const float ratio = __builtin_amdgcn_rsqf(ssa * (1.f / 512.f) + EPS) * __builtin_amdgcn_sqrtf(ssm * (1.f / 512.f) + EPS);
#pragma unroll
                for (int bj = 0; bj < 2; ++bj) { acc[ai][bj][m][0] = acc[ai][bj][m][0] * ratio; acc[ai][bj][m][1] = acc[ai][bj][m][1] * ratio; }
            }
    }
    __device__ __forceinline__ void operator()(const pg8::f32x4 (&acc)[2][2][4][2], const pg8::Unit& u, int wr, int wc, int fr, int fq) const {
        const int row0 = u.pm * 256 + wr * 64 + fr, colw = u.pn * 256 + wc * 32 + 8 * fq;
#pragma unroll
        for (int ai = 0; ai < 2; ++ai)
#pragma unroll
            for (int m = 0; m < 4; ++m) {
                const int r = row0 + ai * 128 + m * 16;
                const int brow = r < NP ? 0 : 1 + ((r - NP) >> 3);
                const float* gt = mod + (size_t)brow * 6144 + 2048;
                const f32x4 s4 = *(const f32x4*)(SSM + (size_t)r * 4);
                const float ss = (s4[0] + s4[1]) + (s4[2] + s4[3]);
                const float rstd = 1.0f / sqrtf(ss * (1.f / 512.f) + EPS);
                const float* base = r < NP ? xp + (size_t)r * DM : xs + (size_t)(r - NP) * DM;
#pragma unroll
                for (int bj = 0; bj < 2; ++bj) {
                    const int col = colw + bj * 128;
                    const f32x4 x0 = *(const f32x4*)(base + col), x1v = *(const f32x4*)(base + col + 4), g0 = *(const f32x4*)(gt + col) * rstd, g1 = *(const f32x4*)(gt + col + 4) * rstd;
                    *(f32x4*)(x1 + (size_t)r * DM + col) = x0 + g0 * acc[ai][bj][m][0];
                    *(f32x4*)(x1 + (size_t)r * DM + col + 4) = x1v + g1 * acc[ai][bj][m][1];
                }
            }
    }
};
__device__ __forceinline__ void p0_transpose_item(const float* W, int ldw, int col0, int K, bf16* WT, int row_off, const float* kscale, LAS float* scr, int item, int nblk, int lane) {
    const int kb = item / nblk, nb = item % nblk, k0 = 64 * kb, n0 = 32 * nb;
    float tv[32];
#pragma unroll
    for (int i = 0; i < 32; ++i) { const int kk = 2 * i + (lane >> 5); tv[i] = W[(size_t)(k0 + kk) * ldw + col0 + n0 + (lane & 31)]; }
#pragma unroll
    for (int i = 0; i < 32; ++i) { const int kk = 2 * i + (lane >> 5); float v = tv[i]; if (kscale) v *= kscale[k0 + kk]; scr[kk * 33 + (lane & 31)] = v; }
    LDS_WAIT(); asm volatile("" ::: "memory");
    const int c = lane & 7;
#pragma unroll
    for (int j = 0; j < 4; ++j) { const int n = (lane >> 3) + 8 * j; const LAS float* s = scr + (8 * c) * 33 + n;
        u32x4 o; o.x = pk2(s[0 * 33], s[1 * 33]); o.y = pk2(s[2 * 33], s[3 * 33]); o.z = pk2(s[4 * 33], s[5 * 33]); o.w = pk2(s[6 * 33], s[7 * 33]);
        *(u32x4*)(WT + (size_t)(row_off + n0 + n) * K + k0 + 8 * c) = o; }
    LDS_WAIT(); asm volatile("" ::: "memory");
}
__device__ __forceinline__ void cvt512h(const float* src, bf16* dst, int lane) {
    const f32x4 a = *(const f32x4*)(src + 8 * lane), b = *(const f32x4*)(src + 8 * lane + 4);
    typedef _Float16 hv2 __attribute__((ext_vector_type(2)));
    u32x4 w; hv2 t;
    t[0] = (_Float16)a[0]; t[1] = (_Float16)a[1]; w.x = __builtin_bit_cast(unsigned, t); t[0] = (_Float16)a[2]; t[1] = (_Float16)a[3]; w.y = __builtin_bit_cast(unsigned, t);
    t[0] = (_Float16)b[0]; t[1] = (_Float16)b[1]; w.z = __builtin_bit_cast(unsigned, t); t[0] = (_Float16)b[2]; t[1] = (_Float16)b[3]; w.w = __builtin_bit_cast(unsigned, t);
    *(u32x4*)(dst + 8 * lane) = w;
}
__device__ __forceinline__ void cvt512(const float* src, bf16* dst, int lane) {
    const f32x4 a = *(const f32x4*)(src + 8 * lane), b = *(const f32x4*)(src + 8 * lane + 4);
    u32x4 w; w.x = pk2(a[0], a[1]); w.y = pk2(a[2], a[3]); w.z = pk2(b[0], b[1]); w.w = pk2(b[2], b[3]);
    *(u32x4*)(dst + 8 * lane) = w;
}
__device__ __forceinline__ void prep_weights_late(const Args& a, LAS unsigned char* lds, int wave, int lane, int widx, int nwork) {
    unsigned char* ws = a.ws;
    LAS float* scr = (LAS float*)(lds + wave * 16384);
    bf16* WoutT = (bf16*)(ws + WS_WOUT); bf16* WpqT = (bf16*)(ws + WS_WPQ); bf16* KEYS = (bf16*)(ws + WS_KEYS);
    for (int it = widx; it < 512 + 1024 + 512; it += nwork) {
        int r = it;
        if (r < 512) { const int hf = r >> 8;
            p0_transpose_item(a.in[15] + (size_t)hf * 512 * 1024, 1024, 0, 512, WoutT + (size_t)hf * 1024 * 512, 0, a.in[14] + hf * 512, scr, r & 255, 32, lane); continue; }
        r -= 512;
        if (r < 1024) { p0_transpose_item(a.in[17], 2048, 0, DM, WpqT, 0, nullptr, scr, r, 64, lane); continue; }
        r -= 1024;
        const int side = r >= 256 ? 1 : 0; if (side) r -= 256;
        const int h = r >> 5, rem = r & 31;
        cvt512(a.in[18 + side] + (size_t)h * 16384 + rem * 512, KEYS + (size_t)(h * 2 + side) * 16384 + rem * 512, lane);
    }
}
__device__ __forceinline__ void prep_tables(const Args& a, int lane, int widx, int nwork, int it_lo, int it_hi) {
    unsigned char* ws = a.ws;
    float* SCU = (float*)(ws + WS_CH) + 65536; float* SCV = (float*)(ws + WS_CH) + 131072;
    for (int it = it_lo + widx; it < it_hi; it += nwork) {
        const int tb = it >= 4096 ? 1 : 0; const int row0 = 4 * (it - tb * 4096);
        const float* src = a.in[20 + tb] + (size_t)row0 * DM + 16 * lane; unsigned char* dst = (unsigned char*)(ws + (tb ? WS_V : WS_U)) + (size_t)row0 * DM + 16 * lane;
        f32x4 v[4][4];
#pragma unroll
        for (int r = 0; r < 4; ++r)
#pragma unroll
            for (int q = 0; q < 4; ++q) v[r][q] = *(const f32x4*)(src + (size_t)r * DM + 4 * q);
#pragma unroll
        for (int r = 0; r < 4; ++r) {
            float am = 0.f;
#pragma unroll
            for (int q = 0; q < 4; ++q) am = fmaxf(fmaxf(am, fmaxf(fabsf(v[r][q][0]), fabsf(v[r][q][1]))), fmaxf(fabsf(v[r][q][2]), fabsf(v[r][q][3])));
#pragma unroll
            for (int o = 1; o < 64; o <<= 1) am = fmaxf(am, __shfl_xor(am, o));
            const float inv = am > 0.f ? 127.f / am : 0.f;
            u32x4 w;
#pragma unroll
            for (int q = 0; q < 4; ++q) { unsigned pk = 0;
#pragma unroll
                for (int e = 0; e < 4; ++e) pk |= ((unsigned)(int)rintf(v[r][q][e] * inv) & 0xffu) << (8 * e);
                w[q] = pk; }
            *(u32x4*)(dst + (size_t)r * DM) = w;
            if (lane == 0) (tb ? SCV : SCU)[row0 + r] = am * (1.f / 127.f);
        }
    }
}
__device__ __forceinline__ void phase0(const Args& a, LAS unsigned char* lds, int tid, int wave, int lane, int vcu, int G, int pmask) {
    unsigned char* ws = a.ws;
    float* mod = (float*)(ws + WS_MOD);
    {
        const float* cp = a.in[7]; const float* cs = a.in[8]; const float* wada = a.in[9]; const float* bada = a.in[10];
        LAS float* scr = (LAS float*)(lds + wave * 8704);
        LAS float* RED = (LAS float*)(lds + 81920);
        const int i16 = lane & 15, g = lane >> 4;
        for (int u = vcu; u < ((pmask & 1) ? 192 : 0); u += G) {
            const int n0 = 32 * u;
            f32x4 acc[2][9];
#pragma unroll
            for (int nt = 0; nt < 2; ++nt)
#pragma unroll
                for (int bt = 0; bt < 9; ++bt) acc[nt][bt] = (f32x4){0.f, 0.f, 0.f, 0.f};
#pragma unroll 1
            for (int ch = 0; ch < 2; ++ch) {
                const int k0 = 128 * wave + 64 * ch;
#pragma unroll 8
                for (int i = 0; i < 32; ++i) { const int kk = 2 * i + (lane >> 5); scr[kk * 33 + (lane & 31)] = wada[(size_t)(k0 + kk) * 6144 + n0 + (lane & 31)]; }
                LDS_WAIT(); asm volatile("" ::: "memory");
#pragma unroll
                for (int ks = 0; ks < 2; ++ks) {
                    bf16x8 ah[2], al[2];
#pragma unroll
                    for (int nt = 0; nt < 2; ++nt) { float v[8]; unsigned hb[8], lb[8];
#pragma unroll
                        for (int j = 0; j < 8; ++j) { v[j] = scr[(32 * ks + 8 * g + j) * 33 + 16 * nt + i16]; hb[j] = f2bf(v[j]); lb[j] = f2bf(v[j] - __uint_as_float(hb[j] << 16)); }
                        u32x4 wh, wl; wh.x = hb[0] | (hb[1] << 16); wh.y = hb[2] | (hb[3] << 16); wh.z = hb[4] | (hb[5] << 16); wh.w = hb[6] | (hb[7] << 16);
                        wl.x = lb[0] | (lb[1] << 16); wl.y = lb[2] | (lb[3] << 16); wl.z = lb[4] | (lb[5] << 16); wl.w = lb[6] | (lb[7] << 16);
                        ah[nt] = __builtin_bit_cast(bf16x8, wh); al[nt] = __builtin_bit_cast(bf16x8, wl); }
#pragma unroll
                    for (int bt = 0; bt < 9; ++bt) {
                        const int b = 16 * bt + i16; const int k = k0 + 32 * ks + 8 * g;
                        f32x4 c0 = {0.f, 0.f, 0.f, 0.f}, c1 = c0;
                        if (b < 129) { const float* cr = b == 0 ? cp + k : cs + (size_t)(b - 1) * DM + k; c0 = *(const f32x4*)cr; c1 = *(const f32x4*)(cr + 4); }
                        unsigned hb[8], lb[8];
#pragma unroll
                        for (int j = 0; j < 8; ++j) { const float c = j < 4 ? c0[j & 3] : c1[j & 3]; const float sv = c * __builtin_amdgcn_rcpf(1.f + __expf(-c)); hb[j] = f2bf(sv); lb[j] = f2bf(sv - __uint_as_float(hb[j] << 16)); }
                        u32x4 wh, wl; wh.x = hb[0] | (hb[1] << 16); wh.y = hb[2] | (hb[3] << 16); wh.z = hb[4] | (hb[5] << 16); wh.w = hb[6] | (hb[7] << 16);
                        wl.x = lb[0] | (lb[1] << 16); wl.y = lb[2] | (lb[3] << 16); wl.z = lb[4] | (lb[5] << 16); wl.w = lb[6] | (lb[7] << 16);
                        const bf16x8 bh = __builtin_bit_cast(bf16x8, wh), bl = __builtin_bit_cast(bf16x8, wl);
#pragma unroll
                        for (int nt = 0; nt < 2; ++nt) { acc[nt][bt] = mfma16(ah[nt], bh, acc[nt][bt]); acc[nt][bt] = mfma16(ah[nt], bl, acc[nt][bt]); acc[nt][bt] = mfma16(al[nt], bh, acc[nt][bt]); }
                    }
                }
                LDS_WAIT(); asm volatile("" ::: "memory");
            }
            __syncthreads();
            for (int r = 0; r < 2; ++r) {
                if ((wave >> 2) == r) {
                    LAS float* RG = (LAS float*)lds + (wave & 3) * (32 * 145);
#pragma unroll
                    for (int nt = 0; nt < 2; ++nt)
#pragma unroll
                        for (int bt = 0; bt < 9; ++bt)
#pragma unroll
                            for (int e = 0; e < 4; ++e) { LAS float* pp = RG + (16 * nt + 4 * g + e) * 145 + 16 * bt + i16; *pp = (r == 0 ? 0.f : *pp) + acc[nt][bt][e]; }
                }
                __syncthreads();
            }
            { const int n = tid & 31, bg = tid >> 5; const float bb = bada[n0 + n];
#pragma unroll
              for (int i = 0; i < 9; ++i) { const int b = bg * 9 + i; const LAS float* r0 = (const LAS float*)lds + n * 145 + b;
                  if (b < 129) mod[(size_t)b * 6144 + n0 + n] = ((r0[0] + r0[32 * 145]) + (r0[2 * 32 * 145] + r0[3 * 32 * 145])) + bb; } }
            __syncthreads();
        }
        __syncthreads();
    }
    const int gw = vcu * NWAVES + wave, NGW = G * NWAVES;
    {
        LAS float* scr = (LAS float*)(lds + wave * 16384);
        bf16* WinT = (bf16*)(ws + WS_WIN);
        for (int r = gw; r < ((pmask & 2) ? 7 * 256 : 0); r += NGW) {
            const int blk = r >> 8; const int src_col = blk == 0 ? 0 : blk == 1 ? 512 : blk == 2 ? 1536 : blk == 3 ? 3072 : blk == 4 ? 2048 : blk == 5 ? 2560 : 1024;
            p0_transpose_item(a.in[12], 3592, src_col, DM, WinT, 512 * blk, nullptr, scr, r & 255, 16, lane);
        }
    }
    float* rope = (float*)(ws + WS_ROPE);
    for (int i = vcu * NTHREADS + tid; i < ((pmask & 8) ? (NP + 8) * 8 : 0); i += G * NTHREADS) {
        const int pi = i >> 3, f = i & 7; const double pos = pi < NP ? (double)pi : (double)(8192 + (pi - NP));
        const double invf = f == 0 ? 1.0 : f == 1 ? 0.19392274474868576 : f == 2 ? 0.03760603093086393 : f == 3 ? 0.007292664737217109 : f == 4 ? 0.001414213562373095
                          : f == 5 ? 0.0002742481756762073 : f == 6 ? 5.318295896944988e-05 : 1.031338537721246e-05;
        const double ang = pos * invf;
        rope[(size_t)pi * 16 + f] = (float)cos(ang); rope[(size_t)pi * 16 + 8 + f] = (float)sin(ang);
    }
}
template <bool FIRST>
__device__ __forceinline__ void phase_norm(const Args& a, LAS unsigned char* lds, int tid, int wave, int lane, int vcu, int G) {
    unsigned char* ws = a.ws;
    const float* mod = (const float*)(ws + WS_MOD);
    const float* gvec = a.in[FIRST ? 11 : 16];
    bf16* H = (bf16*)(ws + WS_H);
    LAS float* WG = (LAS float*)lds;
    if (FIRST) {
        for (int i = tid; i < DM * 8; i += NTHREADS) WG[(i & 7) * DM + (i >> 3)] = a.in[12][(size_t)(i >> 3) * 3592 + 3584 + (i & 7)];
        __syncthreads();
    }
    const int sh_off = FIRST ? 0 : 3072, sc_off = FIRST ? 1024 : 4096;
    const int gw = vcu * NWAVES + wave, NGW = G * NWAVES;
    const int nit = G == 256 ? 5 : (MT + 2 * NGW - 1) / (2 * NGW);
    for (int it = 0; it < nit; ++it) {
        int rr[2];
#pragma unroll
        for (int k = 0; k < 2; ++k) { const int slot = 2 * it + k;
            rr[k] = G == 256 ? ((slot < 8 || (slot == 8 && wave < 4)) ? 68 * vcu + (slot < 8 ? wave + 8 * slot : 64 + wave) : MT) : gw + slot * NGW; }
        f32x4 vv[2][4];
#pragma unroll
        for (int k = 0; k < 2; ++k) { const int r = rr[k]; if (r < MT) {
            const float* xrow = FIRST ? (r < NP ? a.in[0] + (size_t)r * DM : a.in[1] + (size_t)(r - NP) * DM) : (const float*)(ws + WS_X1) + (size_t)r * DM;
#pragma unroll
            for (int j = 0; j < 4; ++j) vv[k][j] = *(const f32x4*)(xrow + 4 * lane + 256 * j); } }
#pragma unroll
        for (int k = 0; k < 2; ++k) { const int r = rr[k]; if (r < MT) {
        const int brow = r < NP ? 0 : 1 + ((r - NP) >> 3);
        const float* mrow = mod + (size_t)brow * 6144;
        float ss = 0.f;
#pragma unroll
        for (int j = 0; j < 4; ++j) ss += (vv[k][j][0] * vv[k][j][0] + vv[k][j][1] * vv[k][j][1]) + (vv[k][j][2] * vv[k][j][2] + vv[k][j][3] * vv[k][j][3]);
        const float rstd = 1.0f / sqrtf(wave_sum(ss) * (1.f / DM) + EPS);
        float gp[8];
#pragma unroll
        for (int e = 0; e < 8; ++e) gp[e] = 0.f;
#pragma unroll
        for (int j = 0; j < 4; ++j) {
            const int c = 4 * lane + 256 * j;
            const f32x4 g = *(const f32x4*)(gvec + c), sc = *(const f32x4*)(mrow + sc_off + c), sh = *(const f32x4*)(mrow + sh_off + c);
            f32x4 h = (vv[k][j] * rstd) * g * (sc + 1.0f) + sh;
            u32x2 w; w.x = pk2(h[0], h[1]); w.y = pk2(h[2], h[3]);
            *(u32x2*)(H + (size_t)r * DM + c) = w;
            if (FIRST) {
#pragma unroll
                for (int e = 0; e < 8; ++e) { const f32x4 w4 = *(const LAS f32x4*)(WG + e * DM + c); gp[e] += (h[0] * w4[0] + h[1] * w4[1]) + (h[2] * w4[2] + h[3] * w4[3]); }
            }
        }
        if (FIRST) {
#pragma unroll
            for (int e = 0; e < 8; ++e) gp[e] = wave_sum(gp[e]);
            if (lane < 4) { const float bi = a.in[13][lane], bf = a.in[13][4 + lane];
                float ig = 0.f, fg = 0.f;
#pragma unroll
                for (int e = 0; e < 4; ++e) { if (lane == e) { ig = gp[e]; fg = gp[4 + e]; } }
                ig += bi; fg += bf;
                const float lf = fminf(fg, 0.f) - log1pf(__expf(-fabsf(fg)));
                ((float*)(ws + WS_IG))[(size_t)r * 4 + lane] = ig; ((float*)(ws + WS_LF))[(size_t)r * 4 + lane] = lf; }
        }
        } }
    }
}
__device__ __forceinline__ float bfv(bf16 v) { return __uint_as_float((unsigned)v << 16); }
template <int MASK> __device__ __forceinline__ void phase3(const Args& a, LAS unsigned char* lds, int tid, int wave, int lane, int vcu, int G) {
    unsigned char* ws = a.ws;
    const bf16* P1 = (const bf16*)(ws + WS_P1); const bf16* PT = (const bf16*)(ws + WS_PT);
    const float* IG = (const float*)(ws + WS_IG); const float* LF = (const float*)(ws + WS_LF);
    const int i16 = lane & 15, g = lane >> 4;
    const int gw = vcu * NWAVES + wave, NGW = G * NWAVES;
    if (MASK & 1) {
        bf16* ATT = (bf16*)(ws + WS_ATT);
        LAS float* ST = (LAS float*)lds;
        struct SState { float m, l; f32x4 o; };
#define SA_UPD(S, sc, mult, v4) do { const float mn_ = fmaxf((S).m, (sc)); const float fo_ = __expf((S).m - mn_), pn_ = (mult) * __expf((sc) - mn_); \
            (S).l = (S).l * fo_ + pn_; (S).o = (S).o * fo_ + (v4) * pn_; (S).m = mn_; } while (0)
#define SA_DOT(qv, kv4, out) do { float d_ = ((qv)[0] * (kv4)[0] + (qv)[1] * (kv4)[1]) + ((qv)[2] * (kv4)[2] + (qv)[3] * (kv4)[3]); \
            d_ += __builtin_bit_cast(float, __builtin_amdgcn_update_dpp(0, __builtin_bit_cast(int, d_), 0xB1, 0xF, 0xF, true)); \
            d_ += __builtin_bit_cast(float, __builtin_amdgcn_update_dpp(0, __builtin_bit_cast(int, d_), 0x4E, 0xF, 0xF, true)); \
            d_ += __builtin_bit_cast(float, __builtin_amdgcn_update_dpp(0, __builtin_bit_cast(int, d_), 0x141, 0xF, 0xF, true)); \
            d_ += __builtin_bit_cast(float, __builtin_amdgcn_update_dpp(0, __builtin_bit_cast(int, d_), 0x140, 0xF, 0xF, true)); (out) = d_; } while (0)
        for (int u = vcu; u < 256; u += G) {
            const int b = u >> 1, h = (u & 1) * 4 + g;
            const float* ck = a.in[2] + ((size_t)b * 2048 + 2048) * 512 + h * 64 + 4 * i16;
            const float* cv = a.in[3] + ((size_t)b * 2048 + 2048) * 512 + h * 64 + 4 * i16;
            const float* kn = a.out + O_KS + (size_t)b * 8 * 512 + h * 64 + 4 * i16;
            const float* vn = a.out + O_VS + (size_t)b * 8 * 512 + h * 64 + 4 * i16;
            f32x4 q[8];
#pragma unroll
            for (int t = 0; t < 8; ++t) { const u32x2 qw = *(const u32x2*)(P1 + (size_t)(NP + b * 8 + t) * P1W + C_AQ + h * 64 + 4 * i16); q[t] = (f32x4){bf_lo(qw.x), bf_hi(qw.x), bf_lo(qw.y), bf_hi(qw.y)}; }
            f32x4 qown = q[0];
#pragma unroll
            for (int t = 1; t < 8; ++t) if (wave == t) qown = q[t];
            const int r4 = wave & 3;
            SState sF, sM0, sM1, sN[8];
            sF.m = -1e30f; sF.l = 0.f; sF.o = (f32x4){0.f, 0.f, 0.f, 0.f}; sM0 = sF; sM1 = sF;
#pragma unroll
            for (int t = 0; t < 8; ++t) sN[t] = sF;
            for (int j0 = 33; j0 < 129; j0 += 8) {
                f32x4 kv[8], vv[8];
#pragma unroll
                for (int x = 0; x < 8; ++x) { const long p = wave - 16 * (j0 + x); kv[x] = __builtin_nontemporal_load((const f32x4*)(ck + p * 512)); vv[x] = __builtin_nontemporal_load((const f32x4*)(cv + p * 512)); }
#pragma unroll
                for (int x = 0; x < 8; ++x) { float sc; SA_DOT(qown, kv[x], sc); SA_UPD(sF, sc, 1.f, vv[x]); }
            }
            {
                f32x4 qa = q[0], qb = q[4];
#pragma unroll
                for (int t = 1; t < 4; ++t) if (r4 == t) { qa = q[t]; qb = q[t + 4]; }
                const int ibase = 33 + 48 * (wave >> 2);
                for (int i0 = 0; i0 < 48; i0 += 8) {
                    f32x4 kv[8], vv[8];
#pragma unroll
                    for (int x = 0; x < 8; ++x) { const long p = r4 - 4 * (ibase + i0 + x); kv[x] = __builtin_nontemporal_load((const f32x4*)(ck + p * 512)); vv[x] = __builtin_nontemporal_load((const f32x4*)(cv + p * 512)); }
#pragma unroll
                    for (int x = 0; x < 8; ++x) {
                        const int da = 4 * (ibase + i0 + x), db = da + 4;
                        const float ma = (da <= 512 ? 1.f : 0.f) + ((da & 15) == 0 ? 1.f : 0.f), mb = (db <= 512 ? 1.f : 0.f) + ((db & 15) == 0 ? 1.f : 0.f);
                        float sa, sb; SA_DOT(qa, kv[x], sa); SA_DOT(qb, kv[x], sb);
                        if (ma > 0.f) SA_UPD(sM0, sa, ma, vv[x]);
                        if (mb > 0.f) SA_UPD(sM1, sb, mb, vv[x]);
                    }
                }
            }
            for (int i0 = 0; i0 < 20; i0 += 4) {
                f32x4 kv[4], vv[4];
#pragma unroll
                for (int x = 0; x < 4; ++x) { int i = i0 + x; i = i < 17 ? i : 16; const long p = -128 + 17 * wave + i;
                    kv[x] = *(const f32x4*)(p < 0 ? ck + p * 512 : kn + p * 512); vv[x] = *(const f32x4*)(p < 0 ? cv + p * 512 : vn + p * 512); }
#pragma unroll
                for (int x = 0; x < 4; ++x) {
                    const int i = i0 + x; const bool rowok = i < 17; const int p = -128 + 17 * wave + (rowok ? i : 16);
#pragma unroll
                    for (int t = 0; t < 8; ++t) {
                        const int dist = t - p;
                        const float mult = rowok && dist >= 0 ? ((dist <= 128 ? 1.f : 0.f) + (((dist & 3) == 0 && dist <= 512) ? 1.f : 0.f) + (((dist & 15) == 0) ? 1.f : 0.f)) : 0.f;
                        if (mult > 0.f) { float sc; SA_DOT(q[t], kv[x], sc); SA_UPD(sN[t], sc, mult, vv[x]); }
                    }
                }
            }
            if (wave < 4) { const float mn = fmaxf(sM0.m, sF.m), f0 = __expf(sM0.m - mn), f1 = __expf(sF.m - mn); sM0.l = sM0.l * f0 + sF.l * f1; sM0.o = sM0.o * f0 + sF.o * f1; sM0.m = mn; }
            else          { const float mn = fmaxf(sM1.m, sF.m), f0 = __expf(sM1.m - mn), f1 = __expf(sF.m - mn); sM1.l = sM1.l * f0 + sF.l * f1; sM1.o = sM1.o * f0 + sF.o * f1; sM1.m = mn; }
            __syncthreads();
            {
                LAS float* mine = ST + (size_t)wave * (10 * 384) + lane * 6;
#define SA_PUT(slot, S) do { LAS float* p_ = mine + (slot) * 384; p_[0] = (S).m; p_[1] = (S).l; p_[2] = (S).o[0]; p_[3] = (S).o[1]; p_[4] = (S).o[2]; p_[5] = (S).o[3]; } while (0)
                SA_PUT(0, sM0); SA_PUT(1, sM1);
#pragma unroll
                for (int t = 0; t < 8; ++t) SA_PUT(2 + t, sN[t]);
            }
            __syncthreads();
            {
                const int t = wave;
                SState acc; acc.m = -1e30f; acc.l = 0.f; acc.o = (f32x4){0.f, 0.f, 0.f, 0.f};
#pragma unroll
                for (int k = 0; k < 10; ++k) {
                    const int srcw = k < 8 ? k : (t & 3) + 4 * (k - 8), slot = k < 8 ? 2 + t : (t < 4 ? 0 : 1);
                    const LAS float* p_ = ST + (size_t)srcw * (10 * 384) + slot * 384 + lane * 6;
                    const float m2 = p_[0], l2 = p_[1]; const f32x4 o2 = {p_[2], p_[3], p_[4], p_[5]};
                    const float mn = fmaxf(acc.m, m2), f0 = __expf(acc.m - mn), f1 = __expf(m2 - mn);
                    acc.l = acc.l * f0 + l2 * f1; acc.o = acc.o * f0 + o2 * f1; acc.m = mn;
                }
                const float inv = 1.f / acc.l; const float o0 = acc.o[0] * inv, o1 = acc.o[1] * inv, o2 = acc.o[2] * inv, o3 = acc.o[3] * inv;
                float sq = (o0 * o0 + o1 * o1) + (o2 * o2 + o3 * o3); sq += __shfl_xor(sq, 1); sq += __shfl_xor(sq, 2); sq += __shfl_xor(sq, 4); sq += __shfl_xor(sq, 8);
                u32x2 w; w.x = pk2(o0, o1); w.y = pk2(o2, o3); *(u32x2*)(ATT + (size_t)(NP + b * 8 + t) * 512 + h * 64 + 4 * i16) = w;
                if (i16 == 0) ((float*)(ws + WS_SSA))[(size_t)(NP + b * 8 + t) * 8 + h] = sq;
            }
        }
        __syncthreads();
    }
    if (MASK & 2) {
        LAS float* wl = (LAS float*)lds; LAS unsigned char* LK = lds + 1024;
        float* BS = (float*)(ws + WS_BS); float* CMB = (float*)(ws + WS_CMB); float* CH = (float*)(ws + WS_CH);
        float* DC = (float*)(ws + WS_DC); float* DN = (float*)(ws + WS_DN);
        for (int u = vcu; u < 512; u += G) {
            const int c = u >> 2, hd = u & 3;
            __syncthreads();
            for (int x = tid; x < 128 * 16; x += NTHREADS) { const int row = x >> 4, ch = x & 15;
                *(LAS u32x4*)(LK + row * 272 + 16 * ch) = *(const u32x4*)(P1 + ((size_t)128 * c + row) * P1W + C_MK + hd * 128 + 8 * ch); }
            if (wave == 0) {
                const int t = 128 * c + 2 * lane;
                const float lf0 = LF[(size_t)t * 4 + hd], lf1 = LF[(size_t)(t + 1) * 4 + hd], ig0 = IG[(size_t)t * 4 + hd], ig1 = IG[(size_t)(t + 1) * 4 + hd];
                float S = lf0 + lf1;
#pragma unroll
                for (int o = 1; o < 64; o <<= 1) { const float n = __shfl_up(S, o); if (lane >= o) S += n; }
                const float F1 = S, F0 = S - lf1, b0 = ig0 - F0, b1 = ig1 - F1;
                float Mx = fmaxf(b0, b1);
#pragma unroll
                for (int o = 1; o < 64; o <<= 1) { const float n = __shfl_up(Mx, o); if (lane >= o) Mx = fmaxf(Mx, n); }
                float Mp = __shfl_up(Mx, 1); if (lane == 0) Mp = -INFINITY;
                const float cm0 = fmaxf(Mp, b0), cm1 = Mx;
                const float FL = __shfl(S, 63), cmL = __shfl(Mx, 63);
                BS[(size_t)t * 4 + hd] = b0; BS[(size_t)(t + 1) * 4 + hd] = b1; CMB[(size_t)t * 4 + hd] = cm0; CMB[(size_t)(t + 1) * 4 + hd] = cm1;
                if (lane == 0) { CH[c * 4 + hd] = FL; CH[1024 + c * 4 + hd] = cmL; }
                wl[2 * lane] = __expf(b0 - cmL); wl[2 * lane + 1] = __expf(b1 - cmL);
            }
            __syncthreads();
            f32x4 acc[8], accn[8];
#pragma unroll
            for (int n = 0; n < 8; ++n) { acc[n] = (f32x4){0.f, 0.f, 0.f, 0.f}; accn[n] = acc[n]; }
            const bf16* vt = PT + (size_t)(R_MVT + hd * 128 + 16 * wave + i16) * MT + 128 * c + 8 * g;
            const int q4 = i16 >> 2, p4 = i16 & 3;
#pragma unroll
            for (int ks = 0; ks < 4; ++ks) {
                const u32x4 aw = __builtin_bit_cast(u32x4, ldfrag(vt + 32 * ks));
                const f32x4 w0 = *(const LAS f32x4*)(wl + 32 * ks + 8 * g), w1 = *(const LAS f32x4*)(wl + 32 * ks + 8 * g + 4);
                u32x4 as, a1;
                as.x = pk2(bf_lo(aw.x) * w0[0], bf_hi(aw.x) * w0[1]); as.y = pk2(bf_lo(aw.y) * w0[2], bf_hi(aw.y) * w0[3]);
                as.z = pk2(bf_lo(aw.z) * w1[0], bf_hi(aw.z) * w1[1]); as.w = pk2(bf_lo(aw.w) * w1[2], bf_hi(aw.w) * w1[3]);
                a1.x = pk2(w0[0], w0[1]); a1.y = pk2(w0[2], w0[3]); a1.z = pk2(w1[0], w1[1]); a1.w = pk2(w1[2], w1[3]);
                const bf16x8 af = __builtin_bit_cast(bf16x8, as), af1 = __builtin_bit_cast(bf16x8, a1);
#pragma unroll
                for (int n = 0; n < 8; ++n) {
                    typedef short v4i16_t __attribute__((ext_vector_type(4)));
                    const v4i16_t lo = __builtin_amdgcn_ds_read_tr16_b64_v4i16((LAS v4i16_t*)(LK + (32 * ks + 8 * g + q4) * 272 + 32 * n + 8 * p4));
                    const v4i16_t hi = __builtin_amdgcn_ds_read_tr16_b64_v4i16((LAS v4i16_t*)(LK + (32 * ks + 8 * g + 4 + q4) * 272 + 32 * n + 8 * p4));
                    const bf16x8 bfr = {lo[0], lo[1], lo[2], lo[3], hi[0], hi[1], hi[2], hi[3]};
                    acc[n] = mfma16(af, bfr, acc[n]); if (wave == 0) accn[n] = mfma16(af1, bfr, accn[n]); }
            }
            float* dc = DC + (size_t)(c * 4 + hd) * 16384;
#pragma unroll
            for (int n = 0; n < 8; ++n)
#pragma unroll
                for (int e = 0; e < 4; ++e) dc[(16 * wave + 4 * g + e) * 128 + 16 * n + i16] = acc[n][e];
            if (wave == 0 && g == 0) {
#pragma unroll
                for (int n = 0; n < 8; ++n) DN[(size_t)(c * 4 + hd) * 128 + 16 * n + i16] = accn[n][0];
            }
        }
        __syncthreads();
    }
    if (MASK & 4) {
        LAS float* QS = (LAS float*)lds; LAS float* KS = QS + 1024; LAS float* VS = KS + 1024; LAS float* SC = VS + 1024;
        bf16* HM = (bf16*)(ws + WS_HM); float* SSM = (float*)(ws + WS_SSM); LAS float* HB = SC + 256;
        for (int ub = vcu; ub < 512; ub += G)
            { const int b = ub >> 2, hd = ub & 3;
                __syncthreads();
                for (int i = tid; i < 3072; i += NTHREADS) { const int which = i >> 10, t = (i >> 7) & 7, d = i & 127; const size_t R = NP + 8 * b + t;
                    QS[i] = which == 0 ? bfv(P1[R * P1W + C_MQ + hd * 128 + d]) : which == 1 ? bfv(P1[R * P1W + C_MK + hd * 128 + d]) : bfv(PT[(size_t)(R_MVT + hd * 128 + d) * MT + R]); }
                if (tid == 0) {
                    const float m0 = a.in[6][b * 4 + hd]; float F = 0.f, cm = m0; float bb[8];
#pragma unroll
                    for (int t = 0; t < 8; ++t) { const size_t R = NP + 8 * b + t; F += LF[R * 4 + hd]; bb[t] = IG[R * 4 + hd] - F; cm = fmaxf(cm, bb[t]);
                        SC[t] = F; SC[8 + t] = bb[t]; SC[16 + t] = cm; SC[24 + t] = __expf(m0 - cm); SC[32 + t] = F + cm; }
#pragma unroll
                    for (int s = 0; s < 8; ++s) SC[40 + s] = __expf(bb[s] - cm);
                    SC[48] = __expf(m0 - cm); SC[49] = F + cm;
                }
                __syncthreads();
                if (tid < 64) {
                    const int t = tid >> 3, s = tid & 7; float d = 0.f;
                    for (int k = 0; k < 128; k += 4) { const f32x4 qv = *(const LAS f32x4*)(QS + t * 128 + k), kv = *(const LAS f32x4*)(KS + s * 128 + k); d += (qv[0] * kv[0] + qv[1] * kv[1]) + (qv[2] * kv[2] + qv[3] * kv[3]); }
                    SC[64 + tid] = s <= t ? d * __expf(SC[8 + s] - SC[16 + t]) : 0.f;
                } else if (tid < 128) {
                    const int t = (tid - 64) >> 3, part = tid & 7; float d = 0.f;
                    for (int k = 0; k < 16; ++k) d += a.in[5][(size_t)(b * 4 + hd) * 128 + 16 * part + k] * QS[t * 128 + 16 * part + k];
                    d += __shfl_xor(d, 1); d += __shfl_xor(d, 2); d += __shfl_xor(d, 4);
                    if (part == 0) SC[128 + t] = d;
                }
                const int dv = tid >> 2, qt = tid & 3;
                const float* c0 = a.in[4] + ((size_t)(b * 4 + hd) * 128 + dv) * 128 + 32 * qt;
                f32x4 cr[8];
#pragma unroll
                for (int i = 0; i < 8; ++i) cr[i] = *(const f32x4*)(c0 + 4 * i);
                float cq[8];
#pragma unroll
                for (int t = 0; t < 8; ++t) { float d = 0.f;
#pragma unroll
                    for (int i = 0; i < 8; ++i) { const f32x4 qv = *(const LAS f32x4*)(QS + t * 128 + 32 * qt + 4 * i); d += (cr[i][0] * qv[0] + cr[i][1] * qv[1]) + (cr[i][2] * qv[2] + cr[i][3] * qv[3]); }
                    d += __shfl_xor(d, 1); d += __shfl_xor(d, 2); cq[t] = d; }
                __syncthreads();
                const float decay = SC[48];
#pragma unroll
                for (int i = 0; i < 8; ++i) cr[i] = cr[i] * decay;
#pragma unroll
                for (int s = 0; s < 8; ++s) { const float coef = SC[40 + s] * VS[s * 128 + dv];
#pragma unroll
                    for (int i = 0; i < 8; ++i) cr[i] = cr[i] + *(const LAS f32x4*)(KS + s * 128 + 32 * qt + 4 * i) * coef; }
                float* cdst = a.out + O_CS + ((size_t)(b * 4 + hd) * 128 + dv) * 128 + 32 * qt;
#pragma unroll
                for (int i = 0; i < 8; ++i) *(f32x4*)(cdst + 4 * i) = cr[i];
                if (tid < 128) { float nn = decay * a.in[5][(size_t)(b * 4 + hd) * 128 + tid];
#pragma unroll
                    for (int s = 0; s < 8; ++s) nn += SC[40 + s] * KS[s * 128 + tid];
                    a.out[O_NS + (size_t)(b * 4 + hd) * 128 + tid] = nn; }
                if (tid == 0) a.out[O_MS + b * 4 + hd] = SC[49];
#pragma unroll
                for (int t = 0; t < 8; ++t) if ((t >> 1) == qt) {
                    float num = SC[24 + t] * cq[t], den = SC[24 + t] * SC[128 + t];
#pragma unroll
                    for (int s = 0; s < 8; ++s) { const float w = SC[64 + t * 8 + s]; num += w * VS[s * 128 + dv]; den += w; }
                    const float hh = num / fmaxf(fabsf(den), __expf(-SC[32 + t]));
                    const size_t R = NP + 8 * b + t;
                    const float hv = hh * sigmoidf_(bfv(P1[R * P1W + C_MO + hd * 128 + dv]));
                    HM[R * 512 + hd * 128 + dv] = (bf16)f2bf(hv); HB[t * 128 + dv] = hv;
                }
                __syncthreads();
                if (tid < 64) { const int t = tid >> 3, part = tid & 7; float sq = 0.f;
                    for (int k = 0; k < 16; ++k) { const float v = HB[t * 128 + 16 * part + k]; sq += v * v; }
                    sq += __shfl_xor(sq, 1); sq += __shfl_xor(sq, 2); sq += __shfl_xor(sq, 4);
                    if (part == 0) SSM[(size_t)(NP + 8 * b + t) * 4 + hd] = sq; }
            }
        __syncthreads();
    }
    if (MASK & 8) {
        const bf16* AVT = PT + (size_t)R_AVT * MT; bf16* VT4 = (bf16*)(ws + WS_VT4); bf16* VT16 = (bf16*)(ws + WS_VT16);
        for (int it = gw; it < 512 * 16; it += NGW) {
            const int f = it >> 4, t0 = (it & 15) * 1024;
            const bf16* src = AVT + (size_t)f * MT + t0 + 16 * lane;
            const u32x4 w0 = *(const u32x4*)src, w1 = *(const u32x4*)(src + 8);
            unsigned e[16];
            e[0] = w0.x & 0xffffu; e[1] = w0.x >> 16; e[2] = w0.y & 0xffffu; e[3] = w0.y >> 16; e[4] = w0.z & 0xffffu; e[5] = w0.z >> 16; e[6] = w0.w & 0xffffu; e[7] = w0.w >> 16;
            e[8] = w1.x & 0xffffu; e[9] = w1.x >> 16; e[10] = w1.y & 0xffffu; e[11] = w1.y >> 16; e[12] = w1.z & 0xffffu; e[13] = w1.z >> 16; e[14] = w1.w & 0xffffu; e[15] = w1.w >> 16;
            bf16* d16 = VT16 + (size_t)f * 16384 + (t0 >> 4) + lane;
#pragma unroll
            for (int r = 0; r < 16; ++r) d16[r * 1024] = (bf16)e[r];
#pragma unroll
            for (int r = 0; r < 4; ++r) { u32x2 o; o.x = e[r] | (e[4 + r] << 16); o.y = e[8 + r] | (e[12 + r] << 16);
                *(u32x2*)(VT4 + (size_t)f * 16384 + r * 4096 + (t0 >> 2) + 4 * lane) = o; }
        }
    }
}
template <int BR>
__device__ __forceinline__ void pattn_group(const bf16* P1, const bf16* VTB, LAS float* O, LAS float* Mx, LAS float* Ls, int t0, int h, int gi, int i16, int g) {
    constexpr int dil = BR == 0 ? 1 : (BR == 1 ? 4 : 16);
    int r, ql0, mq0;
    if (BR == 0) { r = 0; ql0 = 16 * gi; mq0 = t0 + 16 * gi; }
    else if (BR == 1) { r = gi & 3; ql0 = 64 * (gi >> 2) + r; mq0 = (t0 >> 2) + 16 * (gi >> 2); }
    else { r = gi; ql0 = r; mq0 = t0 >> 4; }
    const bf16* qrow = P1 + (size_t)((mq0 + i16) * dil + r) * P1W + C_AQ + h * 64 + 8 * g;
    const bf16x8 qf0 = ldfrag(qrow), qf1 = ldfrag(qrow + 32);
    f32x4 s[5][2];
#pragma unroll
    for (int kb = 0; kb < 5; ++kb)
#pragma unroll
        for (int hf = 0; hf < 2; ++hf) {
            int mk = mq0 - 144 + 32 * kb + 8 * (i16 >> 2) + (i16 & 3) + 4 * hf; mk = mk < 0 ? 0 : mk;
            const bf16* krow = P1 + (size_t)(mk * dil + r) * P1W + C_AK + h * 64 + 8 * g;
            f32x4 acc = {0.f, 0.f, 0.f, 0.f};
            acc = mfma16(ldfrag(krow), qf0, acc); acc = mfma16(ldfrag(krow + 32), qf1, acc);
            s[kb][hf] = acc;
        }
    float mx = -1e30f;
#pragma unroll
    for (int kb = 0; kb < 5; ++kb)
#pragma unroll
        for (int hf = 0; hf < 2; ++hf)
#pragma unroll
            for (int e = 0; e < 4; ++e) {
                const int c = -144 + 32 * kb + 8 * g + 4 * hf + e, dist = i16 - c;
                const bool ok = dist >= 0 && dist <= 128 && (mq0 + c) >= 0;
                const float v = ok ? s[kb][hf][e] : -1e30f; s[kb][hf][e] = v; mx = fmaxf(mx, v);
            }
    mx = fmaxf(mx, __shfl_xor(mx, 16)); mx = fmaxf(mx, __shfl_xor(mx, 32));
    float l = 0.f;
#pragma unroll
    for (int kb = 0; kb < 5; ++kb)
#pragma unroll
        for (int hf = 0; hf < 2; ++hf)
#pragma unroll
            for (int e = 0; e < 4; ++e) { const float v = s[kb][hf][e]; const float p = v > -1e29f ? __expf(v - mx) : 0.f; s[kb][hf][e] = p; l += p; }
    l += __shfl_xor(l, 16); l += __shfl_xor(l, 32);
    f32x4 ot[4];
#pragma unroll
    for (int dt = 0; dt < 4; ++dt) ot[dt] = (f32x4){0.f, 0.f, 0.f, 0.f};
#pragma unroll
    for (int kb = 0; kb < 5; ++kb) {
        const bf16x8 pf = pack8(s[kb][0], s[kb][1]);
        int m0 = mq0 - 144 + 32 * kb + 8 * g; m0 = m0 < 0 ? 0 : m0;
#pragma unroll
        for (int dt = 0; dt < 4; ++dt) {
            const int f = h * 64 + 16 * dt + i16;
            const bf16* vrow = BR == 0 ? VTB + (size_t)f * MT + m0 : (BR == 1 ? VTB + (size_t)f * 16384 + r * 4096 + m0 : VTB + (size_t)f * 16384 + r * 1024 + m0);
            ot[dt] = mfma16(ldfrag(vrow), pf, ot[dt]);
        }
    }
    const int ql = ql0 + dil * i16;
    LAS float* orow = O + ql * 68 + 4 * g;
    if (BR == 0) {
#pragma unroll
        for (int dt = 0; dt < 4; ++dt) *(LAS f32x4*)(orow + 16 * dt) = ot[dt];
        if (g == 0) { Mx[ql] = mx; Ls[ql] = l; }
    } else {
        const float Mo = Mx[ql], Lo = Ls[ql], Mn = fmaxf(Mo, mx), fo = __expf(Mo - Mn), fn = __expf(mx - Mn);
#pragma unroll
        for (int dt = 0; dt < 4; ++dt) { const f32x4 v = *(const LAS f32x4*)(orow + 16 * dt); *(LAS f32x4*)(orow + 16 * dt) = v * fo + ot[dt] * fn; }
        if (g == 0) { Mx[ql] = Mn; Ls[ql] = Lo * fo + l * fn; }
    }
}
template <int BR>
__device__ __forceinline__ void pattn_pair(const bf16* P1, const bf16* VTB, LAS float* O, LAS float* Mx, LAS float* Ls, int t0, int h, int pi, int i16, int g) {
    constexpr int dil = BR == 0 ? 1 : 4;
    int r, ql0, mq0;
    if (BR == 0) { r = 0; ql0 = 32 * pi; mq0 = t0 + 32 * pi; }
    else { r = pi & 3; ql0 = 128 * (pi >> 2) + r; mq0 = (t0 >> 2) + 32 * (pi >> 2); }
    bf16x8 qf[2][2];
#pragma unroll
    for (int qt = 0; qt < 2; ++qt) { const bf16* qrow = P1 + (size_t)((mq0 + 16 * qt + i16) * dil + r) * P1W + C_AQ + h * 64 + 8 * g; qf[qt][0] = ldfrag(qrow); qf[qt][1] = ldfrag(qrow + 32); }
    float mrun[2] = {-1e30f, -1e30f}, lrun[2] = {0.f, 0.f};
    f32x4 ot[2][4];
#pragma unroll
    for (int qt = 0; qt < 2; ++qt)
#pragma unroll
        for (int dt = 0; dt < 4; ++dt) ot[qt][dt] = (f32x4){0.f, 0.f, 0.f, 0.f};
    bf16x8 kf[2][2][2], vf[2][4];
#define PP_LOAD(set, kb) do { _Pragma("unroll") for (int hf_ = 0; hf_ < 2; ++hf_) { int mk_ = mq0 - 128 + 32 * (kb) + 8 * (i16 >> 2) + (i16 & 3) + 4 * hf_; mk_ = mk_ < 0 ? 0 : mk_; \
            const bf16* krow_ = P1 + (size_t)(mk_ * dil + r) * P1W + C_AK + h * 64 + 8 * g; kf[set][hf_][0] = ldfrag(krow_); kf[set][hf_][1] = ldfrag(krow_ + 32); } \
        int m0_ = mq0 - 128 + 32 * (kb) + 8 * g; m0_ = m0_ < 0 ? 0 : m0_; \
        _Pragma("unroll") for (int dt_ = 0; dt_ < 4; ++dt_) { const int f_ = h * 64 + 16 * dt_ + i16; vf[set][dt_] = ldfrag(BR == 0 ? VTB + (size_t)f_ * MT + m0_ : VTB + (size_t)f_ * 16384 + r * 4096 + m0_); } } while (0)
#define PP_BLOCK(set, kb) do { f32x4 s[2][2]; \
        _Pragma("unroll") for (int hf = 0; hf < 2; ++hf) _Pragma("unroll") for (int qt = 0; qt < 2; ++qt) { f32x4 acc = {0.f, 0.f, 0.f, 0.f}; \
            acc = mfma16(kf[set][hf][0], qf[qt][0], acc); acc = mfma16(kf[set][hf][1], qf[qt][1], acc); s[hf][qt] = acc; } \
        _Pragma("unroll") for (int qt = 0; qt < 2; ++qt) { float mx = -1e30f; \
            _Pragma("unroll") for (int hf = 0; hf < 2; ++hf) _Pragma("unroll") for (int e = 0; e < 4; ++e) { const int c = -128 + 32 * (kb) + 8 * g + 4 * hf + e, dist = 16 * qt + i16 - c; \
                const bool ok = dist >= 0 && dist <= 128 && (mq0 + c) >= 0; const float v = ok ? s[hf][qt][e] : -1e30f; s[hf][qt][e] = v; mx = fmaxf(mx, v); } \
            mx = fmaxf(mx, __shfl_xor(mx, 16)); mx = fmaxf(mx, __shfl_xor(mx, 32)); \
            const float mn = fmaxf(mrun[qt], mx), fo = __expf(mrun[qt] - mn); float l = 0.f; \
            _Pragma("unroll") for (int hf = 0; hf < 2; ++hf) _Pragma("unroll") for (int e = 0; e < 4; ++e) { const float v = s[hf][qt][e]; const float p = v > -1e29f ? __expf(v - mn) : 0.f; s[hf][qt][e] = p; l += p; } \
            lrun[qt] = lrun[qt] * fo + l; mrun[qt] = mn; const bf16x8 pf = pack8(s[0][qt], s[1][qt]); \
            _Pragma("unroll") for (int dt = 0; dt < 4; ++dt) { ot[qt][dt] = ot[qt][dt] * fo; ot[qt][dt] = mfma16(vf[set][dt], pf, ot[qt][dt]); } } } while (0)
    PP_LOAD(0, 0);
#pragma unroll 1
    for (int kb = 0; kb < 4; kb += 2) {
        PP_LOAD(1, kb + 1); PP_BLOCK(0, kb); __builtin_amdgcn_sched_barrier(0);
        PP_LOAD(0, kb + 2); PP_BLOCK(1, kb + 1); __builtin_amdgcn_sched_barrier(0);
    }
    PP_BLOCK(0, 4);
#undef PP_BLOCK
#undef PP_LOAD
#pragma unroll
    for (int qt = 0; qt < 2; ++qt) {
        float l = lrun[qt]; l += __shfl_xor(l, 16); l += __shfl_xor(l, 32);
        const float mx = mrun[qt];
        const int ql = ql0 + dil * (16 * qt + i16);
        LAS float* orow = O + ql * 68 + 4 * g;
        if (BR == 0) {
#pragma unroll
            for (int dt = 0; dt < 4; ++dt) *(LAS f32x4*)(orow + 16 * dt) = ot[qt][dt];
            if (g == 0) { Mx[ql] = mx; Ls[ql] = l; }
        } else {
            const float Mo = Mx[ql], Lo = Ls[ql], Mn = fmaxf(Mo, mx), fo = __expf(Mo - Mn), fn = __expf(mx - Mn);
#pragma unroll
            for (int dt = 0; dt < 4; ++dt) { const f32x4 v = *(const LAS f32x4*)(orow + 16 * dt); *(LAS f32x4*)(orow + 16 * dt) = v * fo + ot[qt][dt] * fn; }
            if (g == 0) { Mx[ql] = Mn; Ls[ql] = Lo * fo + l * fn; }
        }
    }
}
__device__ __forceinline__ void phase4(const Args& a, LAS unsigned char* lds, int tid, int wave, int lane, int vcu, int G) {
    unsigned char* ws = a.ws;
    const bf16* P1 = (const bf16*)(ws + WS_P1); const bf16* PT = (const bf16*)(ws + WS_PT);
    const bf16* VT4 = (const bf16*)(ws + WS_VT4); const bf16* VT16 = (const bf16*)(ws + WS_VT16);
    bf16* ATT = (bf16*)(ws + WS_ATT);
    const int i16 = lane & 15, g = lane >> 4;
    LAS float* O = (LAS float*)lds; LAS float* Mx = O + 256 * 68; LAS float* Ls = Mx + 256;
    for (int u = vcu; u < 256 + 512; u += G) {
        if (u < 256) {
            LAS float* DEC = (LAS float*)lds; LAS float* SCL = DEC + 128;
            const float* CH = (const float*)(ws + WS_CH); float* MPREV = (float*)(ws + WS_CH) + 2048;
            const int hd = u >> 6;
            __syncthreads();
            if (wave == 0) {
                const int c0 = 2 * lane; const float b0 = CH[c0 * 4 + hd], a0 = b0 + CH[1024 + c0 * 4 + hd], b1 = CH[(c0 + 1) * 4 + hd], a1 = b1 + CH[1024 + (c0 + 1) * 4 + hd];
                float pa = fmaxf(a1, b1 + a0), pb = b0 + b1;
#pragma unroll
                for (int o = 1; o < 64; o <<= 1) { const float qa = __shfl_up(pa, o), qb = __shfl_up(pb, o); if (lane >= o) { pa = fmaxf(pa, pb + qa); pb = pb + qb; } }
                const float mend = fmaxf(pa, pb);
                float mprev0 = __shfl_up(mend, 1); if (lane == 0) mprev0 = 0.f;
                const float mmid = fmaxf(a0, b0 + mprev0);
                DEC[c0] = __expf(b0 + mprev0 - mmid); SCL[c0] = __expf(a0 - mmid); DEC[c0 + 1] = __expf(b1 + mmid - mend); SCL[c0 + 1] = __expf(a1 - mend);
                if ((u & 63) == 0) { MPREV[c0 * 4 + hd] = mprev0; MPREV[(c0 + 1) * 4 + hd] = mmid; if (lane == 63) a.out[O_MP + hd] = mend; }
            }
            __syncthreads();
            const float* DC = (const float*)(ws + WS_DC); bf16* CPREV = (bf16*)(ws + WS_CPREV);
            {
                const int seg = tid >> 7, el = tid & 127; const size_t e0 = (size_t)u * 256 + 2 * el;
                LAS float* CAR = SCL + 128;
                LAS f32x2* LL = (LAS f32x2*)(lds + 8192) + tid;
                f32x2 C = {0.f, 0.f}; float P = 1.f;
#pragma unroll 1
                for (int hb = 0; hb < 2; ++hb) {
                    f32x2 d[16];
#pragma unroll
                    for (int x = 0; x < 16; ++x) d[x] = *(const f32x2*)(DC + (size_t)(32 * seg + 16 * hb + x) * 65536 + e0);
#pragma unroll
                    for (int x = 0; x < 16; ++x) { const int c = 32 * seg + 16 * hb + x; C = C * DEC[c] + d[x] * SCL[c]; P *= DEC[c]; LL[(16 * hb + x) * 512] = C; }
                }
                CAR[(seg * 128 + el) * 3] = C[0]; CAR[(seg * 128 + el) * 3 + 1] = C[1]; CAR[(seg * 128 + el) * 3 + 2] = P;
                __syncthreads();
                f32x2 carry = {0.f, 0.f};
                for (int s2 = 0; s2 < seg; ++s2) { const LAS float* cp = CAR + (s2 * 128 + el) * 3; carry[0] = cp[0] + cp[2] * carry[0]; carry[1] = cp[1] + cp[2] * carry[1]; }
                f32x2 prev = carry; float qd = 1.f;
#pragma unroll 8
                for (int x = 0; x < 32; ++x) { const int c = 32 * seg + x; *(unsigned*)(CPREV + (size_t)c * 65536 + e0) = pk2(prev[0], prev[1]); qd *= DEC[c]; prev = LL[x * 512] + carry * qd; }
                if (seg == 3) *(f32x2*)(a.out + O_CP + e0) = prev;
            }
            if ((u & 63) == 0 && tid < 128) { const int dk = tid;
                const float* DN = (const float*)(ws + WS_DN); float* NPREV = (float*)(ws + WS_NPREV); float n = 0.f;
                for (int c0 = 0; c0 < 128; c0 += 16) { float dn[16];
#pragma unroll
                    for (int x = 0; x < 16; ++x) dn[x] = DN[(size_t)((c0 + x) * 4 + hd) * 128 + dk];
#pragma unroll
                    for (int x = 0; x < 16; ++x) { NPREV[(size_t)((c0 + x) * 4 + hd) * 128 + dk] = n; n = n * DEC[c0 + x] + dn[x] * SCL[c0 + x]; } }
                a.out[O_NP + hd * 128 + dk] = n;
            }
            __syncthreads();
            continue;
        }
        const int au = u - 256; const int h = G == 256 ? (au & 255) >> 5 : au & 7, pb = G == 256 ? 32 * (au >> 8) + (au & 31) : au >> 3, t0 = 256 * pb;
        __syncthreads();
        pattn_pair<0>(P1, PT + (size_t)R_AVT * MT, O, Mx, Ls, t0, h, wave, i16, g);
        __syncthreads();
        pattn_pair<1>(P1, VT4, O, Mx, Ls, t0, h, wave, i16, g);
        __syncthreads();
#pragma unroll
        for (int gg = 0; gg < 2; ++gg) pattn_group<2>(P1, VT16, O, Mx, Ls, t0, h, wave + 8 * gg, i16, g);
        __syncthreads();
        {
            const int ql = tid >> 1, hf = tid & 1; const float inv = 1.f / Ls[ql];
            const LAS float* orow = O + ql * 68 + 32 * hf;
            bf16* dst = ATT + (size_t)(t0 + ql) * 512 + h * 64 + 32 * hf;
            float sq = 0.f;
#pragma unroll
            for (int i = 0; i < 4; ++i) { const f32x4 x = *(const LAS f32x4*)(orow + 8 * i) * inv, y = *(const LAS f32x4*)(orow + 8 * i + 4) * inv; *(u32x4*)(dst + 8 * i) = __builtin_bit_cast(u32x4, pack8(x, y));
                sq += (x[0] * x[0] + x[1] * x[1]) + (x[2] * x[2] + x[3] * x[3]) + (y[0] * y[0] + y[1] * y[1]) + (y[2] * y[2] + y[3] * y[3]); }
            sq += __shfl_xor(sq, 1);
            if (hf == 0) ((float*)(ws + WS_SSA))[(size_t)(t0 + ql) * 8 + h] = sq;
        }
    }
    __syncthreads();
}
__device__ __forceinline__ void phase5(const Args& a, LAS unsigned char* lds, int tid, int wave, int lane, int vcu, int G, int pmode) {
    unsigned char* ws = a.ws;
    const bf16* P1 = (const bf16*)(ws + WS_P1); const bf16* PT = (const bf16*)(ws + WS_PT); const bf16* CPREV = (const bf16*)(ws + WS_CPREV);
    const float* NPREV = (const float*)(ws + WS_NPREV); const float* MPREV = (const float*)(ws + WS_CH) + 2048;
    const float* BS = (const float*)(ws + WS_BS); const float* CMB = (const float*)(ws + WS_CMB); const float* IG = (const float*)(ws + WS_IG);
    bf16* HM = pmode ? (bf16*)(ws + WS_QP) : (bf16*)(ws + WS_HM); float* SSM = pmode ? (float*)(ws + WS_QP + 32 * MiB) : (float*)(ws + WS_SSM);
    const int i16 = lane & 15, g = lane >> 4;
    LAS unsigned char* LK = lds; LAS unsigned char* LV = lds + 34816; LAS unsigned char* LC = lds + 69632;
    LAS float* LB = (LAS float*)(lds + 104448);
    for (int u = vcu; u < 512; u += G) {
        const int c = u >> 2, hd = u & 3, tg = wave, tl = 16 * tg + i16; const size_t t = (size_t)128 * c + tl;
        __syncthreads();
        if (!(pmode & 2)) for (int x = tid; x < 3 * 128 * 16; x += NTHREADS) {
            const int mat = x >> 11, row = (x >> 4) & 127, ch = x & 15;
            const bf16* src = mat == 0 ? P1 + ((size_t)128 * c + row) * P1W + C_MK + hd * 128 + 8 * ch
                            : mat == 1 ? PT + (size_t)(R_MVT + hd * 128 + row) * MT + 128 * c + 8 * ch
                                       : CPREV + ((size_t)(c * 4 + hd) * 128 + row) * 128 + 8 * ch;
            *(LAS u32x4*)(lds + mat * 34816 + row * 272 + 16 * ch) = *(const u32x4*)src;
        }
        if (tid < 128) LB[tid] = BS[((size_t)128 * c + tid) * 4 + hd];
        const float mprev = MPREV[c * 4 + hd], bmax = fmaxf(mprev, CMB[t * 4 + hd]), aint = __expf(mprev - bmax), m_t = (IG[t * 4 + hd] - BS[t * 4 + hd]) + bmax;
        bf16x8 qf[4];
#pragma unroll
        for (int ks = 0; ks < 4; ++ks) qf[ks] = ldfrag(P1 + t * P1W + C_MQ + hd * 128 + 32 * ks + 8 * g);
        u32x2 mo[8];
#pragma unroll
        for (int d = 0; d < 8; ++d) mo[d] = *(const u32x2*)(P1 + t * P1W + C_MO + hd * 128 + 16 * d + 4 * g);
        __syncthreads();
        f32x4 an[8], ac[8];
#pragma unroll
        for (int d = 0; d < 8; ++d) { an[d] = (f32x4){0.f, 0.f, 0.f, 0.f}; ac[d] = an[d]; }
        float nq = 0.f;
#pragma unroll 2
        for (int ks = 0; ks < ((pmode & 4) ? 0 : 4); ++ks) {
#pragma unroll
            for (int d = 0; d < 8; ++d) ac[d] = mfma16(*(const LAS bf16x8*)(LC + (16 * d + i16) * 272 + 64 * ks + 16 * g), qf[ks], ac[d]);
            const u32x4 qw = __builtin_bit_cast(u32x4, qf[ks]); const float* np = NPREV + (size_t)(c * 4 + hd) * 128 + 32 * ks + 8 * g;
            const f32x4 n0 = *(const f32x4*)np, n1 = *(const f32x4*)(np + 4);
            nq += (bf_lo(qw.x) * n0[0] + bf_hi(qw.x) * n0[1]) + (bf_lo(qw.y) * n0[2] + bf_hi(qw.y) * n0[3]) + (bf_lo(qw.z) * n1[0] + bf_hi(qw.z) * n1[1]) + (bf_lo(qw.w) * n1[2] + bf_hi(qw.w) * n1[3]);
        }
        float dsum = 0.f;
        const int nkb = (pmode & 4) ? 0 : (tg >> 1) + 1;
        for (int kb = 0; kb < nkb; ++kb) {
            f32x4 p[2];
#pragma unroll
            for (int hf = 0; hf < 2; ++hf) {
                const int s = 32 * kb + 8 * (i16 >> 2) + (i16 & 3) + 4 * hf;
                f32x4 acc = {0.f, 0.f, 0.f, 0.f};
#pragma unroll
                for (int ks = 0; ks < 4; ++ks) acc = mfma16(*(const LAS bf16x8*)(LK + s * 272 + 64 * ks + 16 * g), qf[ks], acc);
                const f32x4 b4 = *(const LAS f32x4*)(LB + 32 * kb + 8 * g + 4 * hf);
#pragma unroll
                for (int e = 0; e < 4; ++e) { const int sl = 32 * kb + 8 * g + 4 * hf + e; const float w = sl <= tl ? __expf(b4[e] - bmax) : 0.f; const float pv = acc[e] * w; p[hf][e] = pv; dsum += pv; }
            }
            const bf16x8 pf = pack8(p[0], p[1]);
#pragma unroll
            for (int d = 0; d < 8; ++d) an[d] = mfma16(*(const LAS bf16x8*)(LV + (16 * d + i16) * 272 + 64 * kb + 16 * g), pf, an[d]);
        }
        nq += __shfl_xor(nq, 16); nq += __shfl_xor(nq, 32);
        dsum += __shfl_xor(dsum, 16); dsum += __shfl_xor(dsum, 32);
        const float den = dsum + aint * nq, inv = 1.f / fmaxf(fabsf(den), __expf(-m_t));
        float ssq = 0.f;
        LAS unsigned char* LO = lds + 104960 + wave * (16 * 264);
#pragma unroll
        for (int d = 0; d < ((pmode & 8) ? 0 : 8); ++d) {
            const f32x4 hv = (an[d] + ac[d] * aint) * inv;
            float h0 = hv[0], h1 = hv[1], h2 = hv[2], h3 = hv[3];
            if (!(pmode & 16)) { h0 *= sigmoidf_(bf_lo(mo[d].x)); h1 *= sigmoidf_(bf_hi(mo[d].x)); h2 *= sigmoidf_(bf_lo(mo[d].y)); h3 *= sigmoidf_(bf_hi(mo[d].y)); }
            ssq += (h0 * h0 + h1 * h1) + (h2 * h2 + h3 * h3);
            u32x2 o; o.x = pk2(h0, h1); o.y = pk2(h2, h3); *(LAS u32x2*)(LO + i16 * 264 + (16 * d + 4 * g) * 2) = o;
        }
        if (!(pmode & 40)) {
#pragma unroll
            for (int j = 0; j < 4; ++j) { const int tk = (lane >> 4) + 4 * j, ch = lane & 15;
                const u32x2 lo2 = *(const LAS u32x2*)(LO + tk * 264 + 16 * ch), hi2 = *(const LAS u32x2*)(LO + tk * 264 + 16 * ch + 8);
                u32x4 w; w.x = lo2.x; w.y = lo2.y; w.z = hi2.x; w.w = hi2.y;
                *(u32x4*)(HM + ((size_t)128 * c + 16 * tg + tk) * 512 + hd * 128 + 8 * ch) = w; }
        }
        ssq += __shfl_xor(ssq, 16); ssq += __shfl_xor(ssq, 32);
        if (g == 0) SSM[t * 4 + hd] = ssq;
    }
    __syncthreads();
}
template <int MODE>
__device__ __forceinline__ void mini_gemm(const Args& a, LAS unsigned char* lds, int tid, int wave, int lane, int tile) {
    constexpr int NC = MODE == 0 ? 64 : 128, NTW = NC / 32;
    constexpr int BUFB = (64 + NC) * 272;
    unsigned char* ws = a.ws;
    const int i16 = lane & 15, g = lane >> 4, rt = wave & 3, ch = wave >> 2;
    const int rb = tile >> 4, cb = tile & 15;
    const size_t row0 = (size_t)NP + 64 * rb;
    const int col0 = cb * NC;
    const bf16* Asrc0 = MODE == 0 ? (const bf16*)(ws + WS_ATT) : (const bf16*)(ws + WS_H);
    const bf16* Asrc1 = MODE == 0 ? (const bf16*)(ws + WS_HM) : (const bf16*)(ws + WS_H);
    const bf16* Bsrc0 = MODE == 0 ? (const bf16*)(ws + WS_WOUT) : (const bf16*)(ws + WS_WPQ);
    const bf16* Bsrc1 = MODE == 0 ? (const bf16*)(ws + WS_WOUT) + (size_t)1024 * 512 : (const bf16*)(ws + WS_WPQ);
    constexpr int LDA = MODE == 0 ? 512 : 1024;
    constexpr int NCH = (64 + NC) * 16 / NTHREADS;
    u32x4 pre[NCH];
#define MG_FETCH(c) do { _Pragma("unroll") for (int x_ = 0; x_ < NCH; ++x_) { const int id_ = tid + x_ * NTHREADS, r_ = id_ >> 4, p_ = id_ & 15; \
        const int kof_ = MODE == 0 ? 128 * ((c) & 3) : 128 * (c); const bool hi_ = MODE == 0 && (c) >= 4; \
        const bf16* s_ = r_ < 64 ? (hi_ ? Asrc1 : Asrc0) + (row0 + r_) * LDA + kof_ + 8 * p_ : (hi_ ? Bsrc1 : Bsrc0) + (size_t)(col0 + r_ - 64) * LDA + kof_ + 8 * p_; \
        pre[x_] = *(const u32x4*)s_; } } while (0)
#define MG_STORE(buf) do { _Pragma("unroll") for (int x_ = 0; x_ < NCH; ++x_) { const int id_ = tid + x_ * NTHREADS, r_ = id_ >> 4, p_ = id_ & 15; \
        *(LAS u32x4*)(lds + (buf) * BUFB + r_ * 272 + 16 * p_) = pre[x_]; } } while (0)
    f32x4 acc[2][NTW];
#pragma unroll
    for (int h = 0; h < 2; ++h)
#pragma unroll
        for (int n = 0; n < NTW; ++n) acc[h][n] = (f32x4){0.f, 0.f, 0.f, 0.f};
    __syncthreads();
    MG_FETCH(0); MG_STORE(0);
    __syncthreads();
#pragma unroll 1
    for (int c = 0; c < 8; ++c) {
        if (c < 7) MG_FETCH(c + 1);
        const LAS unsigned char* B0 = lds + (c & 1) * BUFB;
        const int hsel = (MODE == 0 && c >= 4) ? 1 : 0;
#pragma unroll
        for (int ks = 0; ks < 4; ++ks) {
            const bf16x8 tf = *(const LAS bf16x8*)(B0 + (16 * rt + i16) * 272 + 64 * ks + 16 * g);
#pragma unroll
            for (int n = 0; n < NTW; ++n) {
                const bf16x8 wf = *(const LAS bf16x8*)(B0 + (64 + ch * (NC / 2) + 16 * n + i16) * 272 + 64 * ks + 16 * g);
                if (hsel) acc[1][n] = mfma16(wf, tf, acc[1][n]); else acc[0][n] = mfma16(wf, tf, acc[0][n]);
            }
        }
        if (c < 7) MG_STORE((c + 1) & 1);
        __syncthreads();
    }
#undef MG_FETCH
#undef MG_STORE
    const size_t r = row0 + 16 * rt + i16;
    if (MODE == 0) {
        const float* SSA = (const float*)(ws + WS_SSA) + r * 8; const float* SSM = (const float*)(ws + WS_SSM) + r * 4;
        const f32x4 s0 = *(const f32x4*)SSA, s1 = *(const f32x4*)(SSA + 4), s2 = *(const f32x4*)SSM;
        const float ra = 1.0f / sqrtf(((s0[0] + s0[1]) + (s0[2] + s0[3]) + (s1[0] + s1[1]) + (s1[2] + s1[3])) * (1.f / 512.f) + EPS);
        const float rm = 1.0f / sqrtf(((s2[0] + s2[1]) + (s2[2] + s2[3])) * (1.f / 512.f) + EPS);
        const int brow = 1 + (int)((r - NP) >> 3);
        const float* gt = (const float*)(ws + WS_MOD) + (size_t)brow * 6144 + 2048;
        const float* xrow = a.in[1] + (r - NP) * DM; float* x1 = (float*)(ws + WS_X1) + r * DM;
#pragma unroll
        for (int n = 0; n < NTW; ++n) { const int col = col0 + ch * (NC / 2) + 16 * n + 4 * g;
            *(f32x4*)(x1 + col) = *(const f32x4*)(xrow + col) + *(const f32x4*)(gt + col) * (acc[0][n] * ra + acc[1][n] * rm); }
    } else {
        bf16* QP = (bf16*)(ws + WS_QP) + r * 2048;
#pragma unroll
        for (int n = 0; n < NTW; ++n) { const int col = col0 + ch * (NC / 2) + 16 * n + 4 * g; const f32x4 v = acc[0][n];
            u32x2 o; o.x = pk2(v[0], v[1]); o.y = pk2(v[2], v[3]); *(u32x2*)(QP + col) = o; }
    }
    __syncthreads();
}
__device__ __forceinline__ int f2key(float f) { const int b = __float_as_int(f); return b ^ ((b >> 31) & 0x7fffffff); }
__device__ __forceinline__ float key2f(int k) { return __int_as_float(k ^ ((k >> 31) & 0x7fffffff)); }
template <int N> __device__ __forceinline__ void merge_desc(int (&k)[N]) {
#pragma unroll
    for (int st = N >> 1; st > 0; st >>= 1)
#pragma unroll
        for (int i = 0; i < N; ++i) { const int j = i ^ st; if (j > i) { const int hi = max(k[i], k[j]), lo = min(k[i], k[j]); k[i] = hi; k[j] = lo; } }
}
template <int N> __device__ __forceinline__ void sort_desc(int (&k)[N]) {
#pragma unroll
    for (int sz = 2; sz <= N; sz <<= 1)
#pragma unroll
        for (int st = sz >> 1; st > 0; st >>= 1)
#pragma unroll
            for (int i = 0; i < N; ++i) { const int j = i ^ st; if (j > i) { const bool desc = (i & sz) == 0 || sz == N; const int hi = max(k[i], k[j]), lo = min(k[i], k[j]); k[i] = desc ? hi : lo; k[j] = desc ? lo : hi; } }
}
template <int N> __device__ __forceinline__ void merge_desc_p(int (&k)[N], int (&p)[N]) {
#pragma unroll
    for (int st = N >> 1; st > 0; st >>= 1)
#pragma unroll
        for (int i = 0; i < N; ++i) { const int j = i ^ st; if (j > i) { const bool sw = k[j] > k[i]; const int ki = sw ? k[j] : k[i], kj = sw ? k[i] : k[j], pi = sw ? p[j] : p[i], pj = sw ? p[i] : p[j]; k[i] = ki; k[j] = kj; p[i] = pi; p[j] = pj; } }
}
template <int N> __device__ __forceinline__ void sort_desc_p(int (&k)[N], int (&p)[N]) {
#pragma unroll
    for (int sz = 2; sz <= N; sz <<= 1)
#pragma unroll
        for (int st = sz >> 1; st > 0; st >>= 1)
#pragma unroll
            for (int i = 0; i < N; ++i) { const int j = i ^ st; if (j > i) { const bool desc = (i & sz) == 0 || sz == N; const bool sw = desc ? (k[j] > k[i]) : (k[j] < k[i]);
                const int ki = sw ? k[j] : k[i], kj = sw ? k[i] : k[j], pi = sw ? p[j] : p[i], pj = sw ? p[i] : p[j]; k[i] = ki; k[j] = kj; p[i] = pi; p[j] = pj; } }
}
__device__ __forceinline__ void side_top16(const LAS unsigned char* KL, const bf16* QP, size_t T0, int h, int side, int i16, int g, int (&top)[16]) {
    f32x4 acc[8];
#pragma unroll
    for (int n = 0; n < 8; ++n) acc[n] = (f32x4){0.f, 0.f, 0.f, 0.f};
    const bf16* qrow = QP + (T0 + i16) * 2048 + h * 256 + side * 128 + 8 * g;
    const LAS unsigned char* krow = KL + side * 34816 + i16 * 272 + 16 * g;
#pragma unroll
    for (int ks = 0; ks < 4; ++ks) { const bf16x8 qf = ldfrag(qrow + 32 * ks);
#pragma unroll
        for (int n = 0; n < 8; ++n) acc[n] = mfma16(*(const LAS bf16x8*)(krow + n * (16 * 272) + 64 * ks), qf, acc[n]); }
    int ka[16], kb[16];
#pragma unroll
    for (int n = 0; n < 4; ++n)
#pragma unroll
        for (int e = 0; e < 4; ++e) { ka[n * 4 + e] = (f2key(acc[n][e]) & ~127) | (16 * n + 4 * g + e); kb[n * 4 + e] = (f2key(acc[n + 4][e]) & ~127) | (16 * (n + 4) + 4 * g + e); }
    sort_desc<16>(ka); sort_desc<16>(kb);
#pragma unroll
    for (int i = 0; i < 16; ++i) top[i] = max(ka[i], kb[15 - i]);
    merge_desc<16>(top);
#pragma unroll
    for (int o = 16; o <= 32; o <<= 1) {
        int oth[16];
#pragma unroll
        for (int i = 0; i < 16; ++i) oth[i] = __shfl_xor(top[15 - i], o);
#pragma unroll
        for (int i = 0; i < 16; ++i) top[i] = max(top[i], oth[i]);
        merge_desc<16>(top);
    }
}
__host__ __device__ constexpr int cand_off(int i) { return i == 0 ? 0 : i == 1 ? 16 : i == 2 ? 24 : i == 3 ? 29 : i == 4 ? 33 : i == 5 ? 36 : i == 6 ? 38 : i == 7 ? 40 : 42 + (i - 8); }
__host__ __device__ constexpr int cand_cnt(int i) { return 16 / (i + 1); }
__device__ __forceinline__ float gelu_erf(float x) { return 0.5f * x * (1.f + erff(x * 0.70710678118654752f)); }
__device__ __forceinline__ void phase9(const Args& a, LAS unsigned char* lds, int tid, int wave, int lane, int vcu, int G) {
    unsigned char* ws = a.ws;
    const bf16* KEYS = (const bf16*)(ws + WS_KEYS); const bf16* QP = (const bf16*)(ws + WS_QP); const bf16* U16 = (const bf16*)(ws + WS_U); const bf16* V16 = (const bf16*)(ws + WS_V);
    const float* X1 = (const float*)(ws + WS_X1); const float* mod = (const float*)(ws + WS_MOD);
    int* SEL_E = (int*)(ws + WS_SELE); float* SEL_G = (float*)(ws + WS_SELG);
    const int i16 = lane & 15, g = lane >> 4;
    LAS unsigned char* KL = lds + 16384;
    for (int u = vcu; u < 8 * (MT / 128); u += G) {
        const int h = u & 7; const size_t T0 = (size_t)(u >> 3) * 128 + 16 * wave;
        __syncthreads();
        for (int c = tid; c < 2 * 128 * 16; c += NTHREADS) { const int row = c >> 4, ch = c & 15;
            *(LAS u32x4*)(KL + (row >> 7) * 34816 + (row & 127) * 272 + 16 * ch) = *(const u32x4*)(KEYS + ((size_t)h * 256 + row) * 128 + 8 * ch); }
        __syncthreads();
        {
            int va[16], vb[16];
            side_top16(KL, QP, T0, h, 0, i16, g, va); __builtin_amdgcn_sched_barrier(0);
            side_top16(KL, QP, T0, h, 1, i16, g, vb); __builtin_amdgcn_sched_barrier(0);
#define CAND_GROUP(dst, lo_) do { _Pragma("unroll") for (int x_ = 0; x_ < 16; ++x_) dst[x_] = (int)0x80000000; \
            _Pragma("unroll") for (int i = 0; i < 16; ++i) _Pragma("unroll") for (int j = 0; j < 16; ++j) if (j < cand_cnt(i) && cand_off(i) + j >= (lo_) && cand_off(i) + j < (lo_) + 16) \
                dst[(cand_off(i) + j) & 15] = (f2key(key2f(va[i] & ~127) + key2f(vb[j] & ~127)) & ~255) | (i * 16 + j); } while (0)
            int k0[16];
            { int k1[16];
              CAND_GROUP(k0, 0); sort_desc<16>(k0); __builtin_amdgcn_sched_barrier(0);
              CAND_GROUP(k1, 16); sort_desc<16>(k1); __builtin_amdgcn_sched_barrier(0);
#pragma unroll
              for (int i = 0; i < 16; ++i) k0[i] = max(k0[i], k1[15 - i]);
              merge_desc<16>(k0); __builtin_amdgcn_sched_barrier(0); }
            { int k2[16];
              { int k3[16];
                CAND_GROUP(k2, 32); sort_desc<16>(k2); __builtin_amdgcn_sched_barrier(0);
                CAND_GROUP(k3, 48); sort_desc<16>(k3); __builtin_amdgcn_sched_barrier(0);
#pragma unroll
                for (int i = 0; i < 16; ++i) k2[i] = max(k2[i], k3[15 - i]);
                merge_desc<16>(k2); __builtin_amdgcn_sched_barrier(0); }
#pragma unroll
              for (int i = 0; i < 16; ++i) k0[i] = max(k0[i], k2[15 - i]);
              merge_desc<16>(k0); __builtin_amdgcn_sched_barrier(0); }
            int p0[16];
            {
                LAS unsigned char* LK = lds + tid * 32;
                u32x4 wa, wb;
#pragma unroll
                for (int q = 0; q < 4; ++q) { wa[q] = (va[4 * q] & 127) | ((va[4 * q + 1] & 127) << 8) | ((va[4 * q + 2] & 127) << 16) | ((va[4 * q + 3] & 127) << 24);
                                              wb[q] = (vb[4 * q] & 127) | ((vb[4 * q + 1] & 127) << 8) | ((vb[4 * q + 2] & 127) << 16) | ((vb[4 * q + 3] & 127) << 24); }
                *(LAS u32x4*)LK = wa; *(LAS u32x4*)(LK + 16) = wb;
#pragma unroll
                for (int r = 0; r < 16; ++r) { const int ci = (k0[r] >> 4) & 15, cj = k0[r] & 15; p0[r] = ((int)LK[ci] << 7) | (int)LK[16 + cj]; }
            }
            const float mx = key2f(k0[0] & ~255); float ex[16], sum = 0.f;
#pragma unroll
            for (int i = 0; i < 16; ++i) { ex[i] = __expf(key2f(k0[i] & ~255) - mx); sum += ex[i]; }
            const float inv = 1.f / sum;
            if (g == 0) {
#pragma unroll
                for (int i = 0; i < 16; ++i) { SEL_E[(T0 + i16) * 128 + h * 16 + i] = p0[i]; SEL_G[(T0 + i16) * 128 + h * 16 + i] = ex[i] * inv; }
            }
        }
    }
    if (G == 256) { if (vcu >= 64) prep_tables(a, lane, (vcu - 64) * NWAVES + wave, 192 * NWAVES, 2048, 8192); }
    else prep_tables(a, lane, vcu * NWAVES + wave, G * NWAVES, 2048, 8192);
}
#define NRANGE 32
#define GTK 3
#define NB 4
__device__ __forceinline__ float b2f(unsigned w, int b) { return (float)(int)(signed char)(w >> (8 * b)); }
__device__ __forceinline__ int dpp_isum63(int v) {
    v += __builtin_amdgcn_update_dpp(0, v, 0xB1, 0xF, 0xF, true);
    v += __builtin_amdgcn_update_dpp(0, v, 0x4E, 0xF, 0xF, true);
    v += __builtin_amdgcn_update_dpp(0, v, 0x141, 0xF, 0xF, true);
    v += __builtin_amdgcn_update_dpp(0, v, 0x140, 0xF, 0xF, true);
    v += __builtin_amdgcn_update_dpp(0, v, 0x142, 0xA, 0xF, false);
    v += __builtin_amdgcn_update_dpp(0, v, 0x143, 0xC, 0xF, false);
    return __builtin_amdgcn_readlane(v, 63);
}
__device__ __forceinline__ float gelu_as(float v) {
    const float av = fabsf(v), t = __builtin_amdgcn_rcpf(av * 0.2316418882f + 1.0f);
    float q = t * 0.5307027145f + (-0.7265760135f); q = q * t + 0.7107068705f; q = q * t + (-0.142248368f); q = q * t + 0.127414796f; q = q * t;
    const float e = __builtin_amdgcn_exp2f((v * v) * (-0.72134752044f)), m = v * (q * e);
    return v < 0.f ? m : v - m;
}
struct PickBuf { u32x4 uq[NB], vq[NB]; float gt, su, sv; };
#define P10_LOAD(buf, tk, k0) do { int ev_[NB]; \
        _Pragma("unroll") for (int x_ = 0; x_ < NB; ++x_) ev_[x_] = (int)PE[(tk) * 128 + (k0) + x_]; \
        { const int em_ = (int)PE[(tk) * 128 + (k0) + (lane & 3)] & emask; buf.gt = PG[(tk) * 128 + (k0) + (lane & 3)]; buf.su = SCU[em_]; buf.sv = SCV[em_]; } \
        _Pragma("unroll") for (int x_ = 0; x_ < NB; ++x_) { const int e_ = __builtin_amdgcn_readfirstlane(ev_[x_]) & emask; \
            buf.uq[x_] = *(const u32x4*)(U8 + (size_t)e_ * DM + 16 * lane); buf.vq[x_] = *(const u32x4*)(V8 + (size_t)e_ * DM + 16 * lane); } } while (0)
#define DPPI(v, ctrl) __builtin_amdgcn_update_dpp(0, (v), (ctrl), 0xF, 0xF, true)
#ifdef PROBE_VALU
#define P10_EXTRA(va_, tk) { const float cz_ = cf_ * zero_; y[tk][4 * e_] += cz_ * b2f(va_, 0); y[tk][4 * e_ + 1] += cz_ * b2f(va_, 1); y[tk][4 * e_ + 2] += cz_ * b2f(va_, 2); y[tk][4 * e_ + 3] += cz_ * b2f(va_, 3); }
#else
#define P10_EXTRA(va_, tk)
#endif
#define P10_COMP(buf, tk) do { int a_[NB]; \
        _Pragma("unroll") for (int x_ = 0; x_ < NB; ++x_) { a_[x_] = 0; \
            _Pragma("unroll") for (int e_ = 0; e_ < 4; ++e_) { const unsigned ha_ = hq[tk][e_], ua_ = buf.uq[x_][e_]; a_[x_] = __builtin_amdgcn_sdot4((int)ha_, (int)ua_, a_[x_], false); } } \
        const bool b0_ = (lane & 1) != 0, b1_ = (lane & 2) != 0; \
        const int r01_ = (b0_ ? a_[1] : a_[0]) + DPPI(b0_ ? a_[0] : a_[1], 0xB1), r23_ = (b0_ ? a_[3] : a_[2]) + DPPI(b0_ ? a_[2] : a_[3], 0xB1); \
        int r_ = (b1_ ? r23_ : r01_) + DPPI(b1_ ? r01_ : r23_, 0x4E); \
        r_ += DPPI(r_, 0x124); r_ += DPPI(r_, 0x128); r_ += __shfl_xor(r_, 16); r_ += __shfl_xor(r_, 32); \
        const float cfv_ = buf.gt * gelu_as((float)r_ * (sh[tk] * buf.su)) * buf.sv; \
        _Pragma("unroll") for (int x_ = 0; x_ < NB; ++x_) { const float cf_ = __builtin_bit_cast(float, __builtin_amdgcn_readlane(__builtin_bit_cast(int, cfv_), x_)); \
            _Pragma("unroll") for (int e_ = 0; e_ < 4; ++e_) { const unsigned va_ = buf.vq[x_][e_]; \
                y[tk][4 * e_] += cf_ * b2f(va_, 0); y[tk][4 * e_ + 1] += cf_ * b2f(va_, 1); y[tk][4 * e_ + 2] += cf_ * b2f(va_, 2); y[tk][4 * e_ + 3] += cf_ * b2f(va_, 3); P10_EXTRA(va_, tk) } } } while (0)
#define P10_LOADU(buf, tk, k0) do { int ev_[NB]; \
        _Pragma("unroll") for (int x_ = 0; x_ < NB; ++x_) ev_[x_] = (int)PE[(tk) * 128 + (k0) + x_]; \
        { const int em_ = (int)PE[(tk) * 128 + (k0) + (lane & 3)] & emask; buf.gt = PG[(tk) * 128 + (k0) + (lane & 3)]; buf.su = SCU[em_]; buf.sv = SCV[em_]; } \
        _Pragma("unroll") for (int x_ = 0; x_ < NB; ++x_) { const int e_ = __builtin_amdgcn_readfirstlane(ev_[x_]) & emask; \
            buf.uq[x_] = *(const u32x4*)(U8 + (size_t)e_ * DM + 16 * lane); } } while (0)
#define P10_COMPU(buf, tk, k0) do { int a_[NB]; \
        _Pragma("unroll") for (int x_ = 0; x_ < NB; ++x_) { a_[x_] = 0; \
            _Pragma("unroll") for (int e_ = 0; e_ < 4; ++e_) { const unsigned ha_ = hq[tk][e_], ua_ = buf.uq[x_][e_]; a_[x_] = __builtin_amdgcn_sdot4((int)ha_, (int)ua_, a_[x_], false); } } \
        const bool b0_ = (lane & 1) != 0, b1_ = (lane & 2) != 0; \
        const int r01_ = (b0_ ? a_[1] : a_[0]) + DPPI(b0_ ? a_[0] : a_[1], 0xB1), r23_ = (b0_ ? a_[3] : a_[2]) + DPPI(b0_ ? a_[2] : a_[3], 0xB1); \
        int r_ = (b1_ ? r23_ : r01_) + DPPI(b1_ ? r01_ : r23_, 0x4E); \
        r_ += DPPI(r_, 0x124); r_ += DPPI(r_, 0x128); r_ += __shfl_xor(r_, 16); r_ += __shfl_xor(r_, 32); \
        const float cfv_ = buf.gt * gelu_as((float)r_ * (sh[tk] * buf.su)) * buf.sv; \
        if (lane < 4) PG[(tk) * 128 + (k0) + lane] = cfv_; } while (0)
#define P10_LOADV(buf, tk, k0) do { int ev_[NB]; \
        _Pragma("unroll") for (int x_ = 0; x_ < NB; ++x_) ev_[x_] = (int)PE[(tk) * 128 + (k0) + x_]; \
        buf.gt = PG[(tk) * 128 + (k0) + (lane & 3)]; \
        _Pragma("unroll") for (int x_ = 0; x_ < NB; ++x_) { const int e_ = __builtin_amdgcn_readfirstlane(ev_[x_]) & emask; \
            buf.vq[x_] = *(const u32x4*)(V8 + (size_t)e_ * DM + 16 * lane); } } while (0)
#define P10_COMPV(buf, tk) do { \
        _Pragma("unroll") for (int x_ = 0; x_ < NB; ++x_) { const float cf_ = __builtin_bit_cast(float, __builtin_amdgcn_readlane(__builtin_bit_cast(int, buf.gt), x_)); \
            _Pragma("unroll") for (int e_ = 0; e_ < 4; ++e_) { const unsigned va_ = buf.vq[x_][e_]; \
                y[tk][4 * e_] += cf_ * b2f(va_, 0); y[tk][4 * e_ + 1] += cf_ * b2f(va_, 1); y[tk][4 * e_ + 2] += cf_ * b2f(va_, 2); y[tk][4 * e_ + 3] += cf_ * b2f(va_, 3); } } } while (0)
#define NSPL 2
#define GL (64 / NSPL)
#define CW (1024 / NSPL)
struct PickBuf2 { u32x4 q[4]; float gt, su, sv, cf[4]; int pd; };
#define P10_LOADU2(buf, tk, k0, h) do { \
        _Pragma("unroll") for (int x_ = 0; x_ < 4; ++x_) { const int e_ = (int)PE[(tk) * 128 + (k0) + NSPL * x_ + gi] & emask; \
            buf.q[x_] = *(const u32x4*)(U8 + (size_t)e_ * DM + CW * (h) + 16 * lq); } \
        { const int pi_ = (tk) * 128 + (k0) + NSPL * (lane & 3) + gi; if ((h) > 0) buf.pd = PD[pi_]; \
          if ((h) == NSPL - 1) { const int em_ = (int)PE[pi_] & emask; buf.gt = PG[pi_]; buf.su = SCU[em_]; buf.sv = SCV[em_]; } } } while (0)
#define P10_COMPU2(buf, tk, k0, h) do { int a_[4]; \
        _Pragma("unroll") for (int x_ = 0; x_ < 4; ++x_) { a_[x_] = 0; \
            _Pragma("unroll") for (int e_ = 0; e_ < 4; ++e_) { const unsigned ha_ = hqh[tk][h][e_], ua_ = buf.q[x_][e_]; a_[x_] = __builtin_amdgcn_sdot4((int)ha_, (int)ua_, a_[x_], false); } } \
        const bool b0_ = (lane & 1) != 0, b1_ = (lane & 2) != 0; \
        const int r01_ = (b0_ ? a_[1] : a_[0]) + DPPI(b0_ ? a_[0] : a_[1], 0xB1), r23_ = (b0_ ? a_[3] : a_[2]) + DPPI(b0_ ? a_[2] : a_[3], 0xB1); \
        int r_ = (b1_ ? r23_ : r01_) + DPPI(b1_ ? r01_ : r23_, 0x4E); \
        r_ += DPPI(r_, 0x124); r_ += DPPI(r_, 0x128); if (GL >= 32) r_ += __shfl_xor(r_, 16); \
        if ((h) > 0) r_ += buf.pd; \
        const int pi_ = (tk) * 128 + (k0) + NSPL * (lane & 3) + gi; \
        if ((h) < NSPL - 1) { if ((lq & ~3) == 0) PD[pi_] = r_; } \
        else { const float cfv_ = buf.gt * gelu_as((float)r_ * (sh[tk] * buf.su)) * buf.sv; if ((lq & ~3) == 0) PG[pi_] = cfv_; } } while (0)
#define P10_LOADV2(buf, tk, k0, h) do { \
        _Pragma("unroll") for (int x_ = 0; x_ < 4; ++x_) { const int e_ = (int)PE[(tk) * 128 + (k0) + NSPL * x_ + gi] & emask; buf.cf[x_] = PG[(tk) * 128 + (k0) + NSPL * x_ + gi]; \
            buf.q[x_] = *(const u32x4*)(V8 + (size_t)e_ * DM + CW * (h) + 16 * lq); } } while (0)
#define P10_COMPV2(buf, tk, Y) do { \
        _Pragma("unroll") for (int x_ = 0; x_ < 4; ++x_) { const float cf_ = buf.cf[x_]; \
            _Pragma("unroll") for (int e_ = 0; e_ < 4; ++e_) { const unsigned va_ = buf.q[x_][e_]; \
                Y[tk][4 * e_] += cf_ * b2f(va_, 0); Y[tk][4 * e_ + 1] += cf_ * b2f(va_, 1); Y[tk][4 * e_ + 2] += cf_ * b2f(va_, 2); Y[tk][4 * e_ + 3] += cf_ * b2f(va_, 3); } } } while (0)
#define KB_ (4 * NSPL)
#define P10_SWEEPU(h) do { PickBuf2 A, B, C, A1, B1, C1; \
        P10_LOADU2(A, 0, 0, h); P10_LOADU2(B, 1, 0, h); P10_LOADU2(C, 2, 0, h); P10_LOADU2(A1, 0, KB_, h); P10_LOADU2(B1, 1, KB_, h); P10_LOADU2(C1, 2, KB_, h); \
        for (int k = 0; k < 128 - 2 * KB_; k += 2 * KB_) { \
            SB_; P10_COMPU2(A, 0, k, h); SB_; P10_LOADU2(A, 0, k + 2 * KB_, h); \
            SB_; P10_COMPU2(B, 1, k, h); SB_; P10_LOADU2(B, 1, k + 2 * KB_, h); \
            SB_; P10_COMPU2(C, 2, k, h); SB_; P10_LOADU2(C, 2, k + 2 * KB_, h); \
            SB_; P10_COMPU2(A1, 0, k + KB_, h); SB_; P10_LOADU2(A1, 0, k + 3 * KB_, h); \
            SB_; P10_COMPU2(B1, 1, k + KB_, h); SB_; P10_LOADU2(B1, 1, k + 3 * KB_, h); \
            SB_; P10_COMPU2(C1, 2, k + KB_, h); SB_; P10_LOADU2(C1, 2, k + 3 * KB_, h); } \
        SB_; P10_COMPU2(A, 0, 128 - 2 * KB_, h); SB_; P10_COMPU2(B, 1, 128 - 2 * KB_, h); SB_; P10_COMPU2(C, 2, 128 - 2 * KB_, h); \
        SB_; P10_COMPU2(A1, 0, 128 - KB_, h); SB_; P10_COMPU2(B1, 1, 128 - KB_, h); SB_; P10_COMPU2(C1, 2, 128 - KB_, h); SB_; } while (0)
#define P10_SWEEPV(h, Y) do { { PickBuf2 A, B, C; \
        P10_LOADV2(A, 0, 0, h); P10_LOADV2(B, 1, 0, h); P10_LOADV2(C, 2, 0, h); \
        for (int k = 0; k < 128 - KB_; k += KB_) { \
            SB_; P10_COMPV2(A, 0, Y); SB_; P10_LOADV2(A, 0, k + KB_, h); \
            SB_; P10_COMPV2(B, 1, Y); SB_; P10_LOADV2(B, 1, k + KB_, h); \
            SB_; P10_COMPV2(C, 2, Y); SB_; P10_LOADV2(C, 2, k + KB_, h); } \
        SB_; P10_COMPV2(A, 0, Y); SB_; P10_COMPV2(B, 1, Y); SB_; P10_COMPV2(C, 2, Y); SB_; } \
        _Pragma("unroll") for (int tk_ = 0; tk_ < GTK; ++tk_) { \
            _Pragma("unroll") for (int q_ = 0; q_ < 4; ++q_) { f32x4 s4_; \
                _Pragma("unroll") for (int e_ = 0; e_ < 4; ++e_) { float v_ = Y[tk_][4 * q_ + e_]; if (NSPL >= 4) v_ += __shfl_xor(v_, 16); v_ += __shfl_xor(v_, 32); s4_[e_] = v_; Y[tk_][4 * q_ + e_] = 0.f; } \
                if (gi == (h)) *(LAS f32x4*)(YS + (tk_ * 64 + lane) * 16 + 4 * q_) = s4_; } } } while (0)
__device__ __forceinline__ void phase10(const Args& a, LAS unsigned char* lds, int tid, int wave, int lane, int vcu, int G, int emask, bool probe) {
    unsigned char* ws = a.ws;
    const unsigned char* U8 = (const unsigned char*)(ws + WS_U); const unsigned char* V8 = (const unsigned char*)(ws + WS_V);
    const float* SCU = (const float*)(ws + WS_CH) + 65536; const float* SCV = (const float*)(ws + WS_CH) + 131072;
    const float* X1 = (const float*)(ws + WS_X1); const float* mod = (const float*)(ws + WS_MOD);
    const int* SEL_E = (const int*)(ws + WS_SELE); const float* SEL_G = (const float*)(ws + WS_SELG);
    const int gw = vcu * NWAVES + wave, NGW = G * NWAVES;
    LAS unsigned short* PE = (LAS unsigned short*)(lds + wave * 4096);
    LAS float* PG = (LAS float*)(lds + wave * 4096 + 1024);
    LAS int* PD = (LAS int*)(lds + wave * 4096 + 2560);
    LAS float* YS = (LAS float*)(lds + 32768 + wave * 12288);
    const int gi = lane / GL, lq = lane % GL;
    const int c0 = 16 * lane;
#ifdef PROBE_VALU
    const float zero_ = (float)a.ph_lo;
#endif
    const int nrounds = G == 256 ? 3 : (MT + GTK * NGW - 1) / (GTK * NGW);
    for (int rd = 0; rd < nrounds; ++rd) {
        u32x4 hq[GTK]; float sh[GTK];
#pragma unroll
        for (int tk = 0; tk < GTK; ++tk) {
            const int slot = GTK * rd + tk;
            const size_t R = G == 256 ? ((slot < 8 || (slot == 8 && wave < 4)) ? (size_t)68 * vcu + (slot < 8 ? wave + 8 * slot : 64 + wave) : (size_t)MT) : (size_t)gw + (size_t)slot * NGW;
            hq[tk] = (u32x4){0u, 0u, 0u, 0u}; sh[tk] = 0.f;
            if (R < MT) {
                const int brow = R < NP ? 0 : 1 + (int)((R - NP) >> 3);
                const float* mrow = mod + (size_t)brow * 6144;
                float x1v[16];
#pragma unroll
                for (int q = 0; q < 4; ++q) { const f32x4 t4 = *(const f32x4*)(X1 + R * DM + c0 + 4 * q);
#pragma unroll
                    for (int e = 0; e < 4; ++e) x1v[4 * q + e] = t4[e]; }
                float ss = 0.f;
#pragma unroll
                for (int e = 0; e < 16; ++e) ss += x1v[e] * x1v[e];
                const float rstd = 1.0f / sqrtf(wave_sum(ss) * (1.f / DM) + EPS);
                float h2[16], am = 0.f;
#pragma unroll
                for (int e = 0; e < 16; ++e) { const int c = c0 + e; h2[e] = x1v[e] * rstd * a.in[16][c] * (1.f + mrow[4096 + c]) + mrow[3072 + c]; am = fmaxf(am, fabsf(h2[e])); }
#pragma unroll
                for (int o = 1; o < 64; o <<= 1) am = fmaxf(am, __shfl_xor(am, o));
                const float inv = am > 0.f ? 127.f / am : 0.f; sh[tk] = am * (1.f / 127.f);
#pragma unroll
                for (int q = 0; q < 4; ++q) { unsigned pk = 0;
#pragma unroll
                    for (int e = 0; e < 4; ++e) pk |= ((unsigned)(int)rintf(h2[4 * q + e] * inv) & 0xffu) << (8 * e);
                    hq[tk][q] = pk; }
                const int e0 = SEL_E[R * 128 + 2 * lane], e1 = SEL_E[R * 128 + 2 * lane + 1]; const float g0 = SEL_G[R * 128 + 2 * lane], g1 = SEL_G[R * 128 + 2 * lane + 1];
                const int r0 = e0 >> 9, r1 = e1 >> 9; int pos0 = 0, pos1 = 0, off = 0;
                const unsigned long long lt = (1ull << lane) - 1ull;
                for (int r = 0; r < NRANGE; ++r) {
                    const unsigned long long m0 = __ballot(r0 == r), m1 = __ballot(r1 == r);
                    if (r0 == r) pos0 = off + __popcll(m0 & lt);
                    if (r1 == r) pos1 = off + __popcll(m0) + __popcll(m1 & lt);
                    off += __popcll(m0) + __popcll(m1);
                }
                PE[tk * 128 + pos0] = (unsigned short)e0; PE[tk * 128 + pos1] = (unsigned short)e1; PG[tk * 128 + pos0] = g0; PG[tk * 128 + pos1] = g1;
            } else { PE[tk * 128 + 2 * lane] = 0; PE[tk * 128 + 2 * lane + 1] = 0; PG[tk * 128 + 2 * lane] = 0.f; PG[tk * 128 + 2 * lane + 1] = 0.f; }
        }
#define SB_ __builtin_amdgcn_sched_barrier(0)
        u32x4 hqh[GTK][NSPL];
#pragma unroll
        for (int tk = 0; tk < GTK; ++tk)
#pragma unroll
            for (int h = 0; h < NSPL; ++h)
#pragma unroll
                for (int e = 0; e < 4; ++e) hqh[tk][h][e] = (unsigned)__shfl((int)hq[tk][e], GL * h + lq);
        P10_SWEEPU(0); P10_SWEEPU(1);
#if NSPL == 4
        P10_SWEEPU(2); P10_SWEEPU(3);
#endif
        float y[GTK][16];
#pragma unroll
        for (int tk = 0; tk < GTK; ++tk)
#pragma unroll
            for (int e = 0; e < 16; ++e) y[tk][e] = 0.f;
        P10_SWEEPV(0, y); P10_SWEEPV(1, y);
#if NSPL == 4
        P10_SWEEPV(2, y); P10_SWEEPV(3, y);
#endif
#pragma unroll
        for (int tk = 0; tk < GTK; ++tk) {
#pragma unroll
            for (int q = 0; q < 4; ++q) { const f32x4 s4 = *(const LAS f32x4*)(YS + (tk * 64 + lane) * 16 + 4 * q);
#pragma unroll
                for (int e = 0; e < 4; ++e) y[tk][4 * q + e] = s4[e]; } }
#pragma unroll
        for (int tk = 0; tk < GTK; ++tk) {
            const int slot = GTK * rd + tk;
            const size_t R = G == 256 ? ((slot < 8 || (slot == 8 && wave < 4)) ? (size_t)68 * vcu + (slot < 8 ? wave + 8 * slot : 64 + wave) : (size_t)MT) : (size_t)gw + (size_t)slot * NGW;
            if (R < MT) {
                const int brow = R < NP ? 0 : 1 + (int)((R - NP) >> 3);
                const float* mrow = mod + (size_t)brow * 6144;
                float xo[16]; float s2 = 0.f;
#pragma unroll
                for (int q = 0; q < 4; ++q) { const f32x4 t4 = *(const f32x4*)(X1 + R * DM + c0 + 4 * q), g4 = *(const f32x4*)(mrow + 5120 + c0 + 4 * q);
#pragma unroll
                    for (int e = 0; e < 4; ++e) { xo[4 * q + e] = t4[e] + g4[e] * y[tk][4 * q + e]; s2 += xo[4 * q + e] * xo[4 * q + e]; } }
                const float r2 = 1.0f / sqrtf(wave_sum(s2) * (1.f / DM) + EPS);
                float* dst = probe ? (float*)(ws + WS_QP) + R * DM : (R < NP ? a.out + O_YP + R * DM : a.out + O_YS + (R - NP) * DM);
#pragma unroll
                for (int q = 0; q < 4; ++q) { const f32x4 gf = *(const f32x4*)(a.in[22] + c0 + 4 * q); f32x4 o;
#pragma unroll
                    for (int e = 0; e < 4; ++e) o[e] = xo[4 * q + e] * r2 * gf[e];
                    *(f32x4*)(dst + c0 + 4 * q) = o; }
            }
        }
    }
}
__global__ void __launch_bounds__(NTHREADS, 2) hymba_fwd(Args args) {
    extern __shared__ __attribute__((aligned(16))) unsigned char lds_raw[];
    LAS unsigned char* lds = (LAS unsigned char*)lds_raw;
    const int tid = threadIdx.x, lane = tid & 63, wave = __builtin_amdgcn_readfirstlane(tid >> 6);
    const int G = gridDim.x; const int bx = blockIdx.x; const int vcu = (G % 8 == 0) ? (bx % 8) * (G / 8) + bx / 8 : bx;
    for (int u = tid; u < (LDS_BYTES - LDSCTL_OFF) / 4; u += NTHREADS) ((LAS unsigned*)(lds + LDSCTL_OFF))[u] = 0u;
    __syncthreads();
    const int lo = args.ph_lo, hi = args.ph_hi;
    XcdBarrier bar; bar.bar = (unsigned*)(args.ws + WS_CTL) + CW_BAR; bar.x = 0; bar.st = nullptr;
    if (hi - lo > 1) bar = xcd_barrier_post((unsigned*)(args.ws + WS_CTL) + CW_BAR, (volatile LAS unsigned*)(lds + LDSCTL_OFF + 64));
#ifdef ONLY_PHASE
#define IN(k) ((k) == ONLY_PHASE)
#else
#define IN(k) (lo <= (k) && (k) < hi)
#endif
#define SEAM(k) do { if (IN(k) && IN((k) + 1)) xcd_barrier(bar); } while (0)
#ifndef PROBE_PHASE
#define PROBE_PHASE -1
#endif
#define NREP(k) ((k) == PROBE_PHASE ? 2 : 1)
#ifndef PROBE_P3MASK
#define PROBE_P3MASK 15
#endif
#ifndef PROBE_P5MODE
#define PROBE_P5MODE 0
#endif
#ifndef PROBE_P0MASK
#define PROBE_P0MASK 15
#endif
#ifndef PROBE_GMODE
#define PROBE_GMODE 0
#endif
    if (IN(0)) for (int rep_ = 0; rep_ < NREP(0); ++rep_) { if (rep_) xcd_barrier(bar); phase0(args, lds, tid, wave, lane, vcu, G, rep_ ? PROBE_P0MASK : 15); } SEAM(0);
    if (IN(1)) for (int rep_ = 0; rep_ < NREP(1); ++rep_) { if (rep_) xcd_barrier(bar); phase_norm<true>(args, lds, tid, wave, lane, vcu, G); } SEAM(1);
    if (IN(2)) for (int rep_ = 0; rep_ < NREP(2); ++rep_) { if (rep_) xcd_barrier(bar);
        unsigned char* ws = args.ws;
        { pg8::Gemm gm{(const pg8::bf16_t*)(ws + WS_H), (const pg8::bf16_t*)(ws + WS_WIN), MT, 2560, DM}; pg8::StaticOrder S; S.init(MT, 2560, G, bx);
          EpiStd E{(bf16*)(ws + WS_P1), (const float*)(ws + WS_ROPE), args.out + O_KP, args.out + O_KS};
          pg8::gemm_phase<EpiStd, pg8::StaticOrder, true, true>(lds, gm, S, E); }
        __syncthreads();
        { pg8::Gemm gm{(const pg8::bf16_t*)(ws + WS_WIN) + (size_t)2560 * DM, (const pg8::bf16_t*)(ws + WS_H), 1024, MT, DM}; pg8::StaticOrder S; S.init(1024, MT, G, (bx + 88) % G);
          EpiTr E{(bf16*)(ws + WS_PT), args.out + O_VP, args.out + O_VS};
          pg8::gemm_phase<EpiTr, pg8::StaticOrder, true, true>(lds, gm, S, E); }
        __syncthreads();
        if (rep_ == 0 && G == 256 && bx >= 184) { prep_weights_late(args, lds, wave, lane, (bx - 184) * NWAVES + wave, 72 * NWAVES);
            prep_tables(args, lane, (bx - 184) * NWAVES + wave, 72 * NWAVES, 0, 2048); }
        else if (rep_ == 0 && G != 256) { prep_weights_late(args, lds, wave, lane, bx * NWAVES + wave, G * NWAVES); prep_tables(args, lane, bx * NWAVES + wave, G * NWAVES, 0, 2048); }
        __syncthreads();
    } SEAM(2);
    if (IN(3)) for (int rep_ = 0; rep_ < NREP(3); ++rep_) { if (rep_) xcd_barrier(bar); if (rep_ == 0) phase3<15>(args, lds, tid, wave, lane, vcu, G); else phase3<PROBE_P3MASK>(args, lds, tid, wave, lane, vcu, G); } SEAM(3);
    if (IN(4)) for (int rep_ = 0; rep_ < NREP(4); ++rep_) { if (rep_) xcd_barrier(bar); phase4(args, lds, tid, wave, lane, vcu, G); } SEAM(4);
    if (IN(5)) for (int rep_ = 0; rep_ < NREP(5); ++rep_) { if (rep_) xcd_barrier(bar); phase5(args, lds, tid, wave, lane, vcu, G, rep_ ? PROBE_P5MODE : 0); } SEAM(5);
    if (IN(6)) for (int rep_ = 0; rep_ < NREP(6); ++rep_) { if (rep_) xcd_barrier(bar);
        unsigned char* ws = args.ws;
        { pg8::Gemm gm{(const pg8::bf16_t*)(ws + WS_ATT), (const pg8::bf16_t*)(ws + WS_WOUT), NP, DM, 512, (const pg8::bf16_t*)(ws + WS_HM), (const pg8::bf16_t*)(ws + WS_WOUT) + (size_t)1024 * 512};
          pg8::PairOrder S; S.S.init(NP, DM, G, bx);
          EpiX1P E{args.in[0], args.in[1], (const float*)(ws + WS_MOD), (const float*)(ws + WS_SSA), (const float*)(ws + WS_SSM), (float*)(ws + WS_X1)};
          pg8::gemm_phase<EpiX1P, pg8::PairOrder, true, true>(lds, gm, S, E); }
        __syncthreads();
        for (int t = vcu; t < 256; t += G) mini_gemm<0>(args, lds, tid, wave, lane, t);
    } SEAM(6);
    if (IN(7)) for (int rep_ = 0; rep_ < NREP(7); ++rep_) { if (rep_) xcd_barrier(bar); phase_norm<false>(args, lds, tid, wave, lane, vcu, G); } SEAM(7);
    if (IN(8)) for (int rep_ = 0; rep_ < NREP(8); ++rep_) { if (rep_) xcd_barrier(bar);
        unsigned char* ws = args.ws;
        pg8::Gemm gm{(const pg8::bf16_t*)(ws + WS_H), (const pg8::bf16_t*)(ws + WS_WPQ), NP, 2048, DM}; pg8::StaticOrder S; S.init(NP, 2048, G, bx);
        pg8::EpiBf16<0> E{(pg8::bf16_t*)(ws + WS_QP), 2048, nullptr, 0, 0, 1.f};
        pg8::gemm_phase<pg8::EpiBf16<0>, pg8::StaticOrder, true, true>(lds, gm, S, E);
        __syncthreads();
        for (int t = vcu; t < 256; t += G) mini_gemm<1>(args, lds, tid, wave, lane, t);
    } SEAM(8);
    if (IN(9)) for (int rep_ = 0; rep_ < NREP(9); ++rep_) { if (rep_) xcd_barrier(bar); phase9(args, lds, tid, wave, lane, vcu, G); } SEAM(9);
    if (IN(10)) for (int rep_ = 0; rep_ < NREP(10); ++rep_) { if (rep_) xcd_barrier(bar); phase10(args, lds, tid, wave, lane, vcu, G, (rep_ && PROBE_GMODE) ? PROBE_GMODE : 0x3fff, rep_ && PROBE_GMODE); }
#undef IN
#undef SEAM
}

extern "C" void kernel_launch(void* const* d_in, const int* in_sizes, int n_in, void* d_out, int out_size, void* d_ws, size_t ws_size, hipStream_t stream) {
    static int grid = 0;
    if (grid == 0) {
        if (n_in != 23 || out_size != (int)O_END || ws_size < WS_END) { fprintf(stderr, "kernel_launch: unexpected shapes (n_in %d, out %d, ws %zu); nothing launched\n", n_in, out_size, ws_size); grid = -1; return; }
        int dev = 0, cus = 0, per_cu = 0;
        if (hipGetDevice(&dev) != hipSuccess || hipDeviceGetAttribute(&cus, hipDeviceAttributeMultiprocessorCount, dev) != hipSuccess) { grid = -1; return; }
        if (hipFuncSetAttribute((const void*)hymba_fwd, hipFuncAttributeMaxDynamicSharedMemorySize, LDS_BYTES) != hipSuccess) { fprintf(stderr, "kernel_launch: hipFuncSetAttribute failed\n"); grid = -1; return; }
        if (hipOccupancyMaxActiveBlocksPerMultiprocessor(&per_cu, (const void*)hymba_fwd, NTHREADS, LDS_BYTES) != hipSuccess || per_cu < 1) { fprintf(stderr, "kernel_launch: occupancy query says %d blocks per CU\n", per_cu); }
        (void)hipGetLastError();
        grid = cus;
    }
    if (grid < 0) return;
    (void)hipMemsetAsync((char*)d_ws + WS_CTL, 0, CTL_ZERO_BYTES, stream);
    Args a{};
    for (int i = 0; i < 23; ++i) a.in[i] = (const float*)d_in[i];
    a.out = (float*)d_out; a.ws = (unsigned char*)d_ws;
#if MK_ONE_LAUNCH
    a.ph_lo = 0; a.ph_hi = NPH;
    hipLaunchKernelGGL(hymba_fwd, dim3(grid), dim3(NTHREADS), LDS_BYTES, stream, a);
#else
    for (int p = 0; p < NPH; ++p) { a.ph_lo = p; a.ph_hi = p + 1; hipLaunchKernelGGL(hymba_fwd, dim3(grid), dim3(NTHREADS), LDS_BYTES, stream, a); }
#endif
}
```

```cpp
#include <hip/hip_runtime.h>
#include <cstdio>
#include <cstdint>
#include <cmath>
#ifndef MK_ONE_LAUNCH
#define MK_ONE_LAUNCH 1
#endif
#define LAS __attribute__((address_space(3)))
#define GAS __attribute__((address_space(1)))
typedef unsigned short bf16;
typedef short bf16x8 __attribute__((ext_vector_type(8)));
typedef float f32x4 __attribute__((ext_vector_type(4)));
typedef float f32x2 __attribute__((ext_vector_type(2)));
typedef unsigned u32x4 __attribute__((ext_vector_type(4)));
typedef unsigned u32x2 __attribute__((ext_vector_type(2)));

constexpr int NP = 16384, NSMP = 1024, MT = NP + NSMP, DM = 1024;
constexpr int NWAVES = 8, NTHREADS = 512, NPH = 11;
constexpr int P1W = 2560;
constexpr int C_AQ = 0, C_AK = 512, C_MQ = 1024, C_MO = 1536, C_MK = 2048;
constexpr int R_MVT = 0, R_AVT = 512;
constexpr size_t MiB = 1u << 20;
constexpr size_t WS_CTL = 0, CTL_ZERO_BYTES = 32 * 1024;
constexpr size_t WS_MOD = 1 * MiB, WS_ROPE = 5 * MiB, WS_IG = 7 * MiB, WS_LF = 8 * MiB, WS_BS = 9 * MiB, WS_CMB = 10 * MiB, WS_CH = 11 * MiB;
constexpr size_t WS_WIN = 12 * MiB, WS_WOUT = 20 * MiB, WS_WPQ = 22 * MiB, WS_KEYS = 26 * MiB, WS_U = 27 * MiB, WS_V = 59 * MiB;
constexpr size_t WS_H = 91 * MiB, WS_P1 = 125 * MiB, WS_PT = 210 * MiB, WS_VT4 = 261 * MiB, WS_VT16 = 277 * MiB, WS_ATT = 293 * MiB, WS_HMS = 310 * MiB;
constexpr size_t WS_MIX = 312 * MiB, WS_X1 = 346 * MiB, WS_QP = 414 * MiB, WS_DC = 482 * MiB, WS_DN = 514 * MiB, WS_CPREV = 515 * MiB, WS_NPREV = 531 * MiB, WS_SELE = 532 * MiB, WS_SELG = 541 * MiB, WS_HM = 550 * MiB, WS_SSA = 567 * MiB, WS_SSM = 568 * MiB, WS_END = 569 * MiB;
constexpr size_t O_YP = 0, O_YS = 16777216, O_KP = 17825792, O_VP = 18874368, O_KS = 19922944, O_VS = 20447232, O_CP = 20971520, O_NP = 21037056, O_MP = 21037568,
                 O_CS = 21037572, O_NS = 29426180, O_MS = 29491716, O_END = 29492228;
constexpr int CW_BAR = 4096;
constexpr int RING_BYTES = 131072, LDS_BYTES = 147456, LDSCTL_OFF = LDS_BYTES - 1024;
constexpr float EPS = 1e-6f;

struct Args { const float* in[23]; float* out; unsigned char* ws; int ph_lo, ph_hi; };

__device__ __forceinline__ unsigned f2bf(float f) { unsigned u = __builtin_bit_cast(unsigned, f); return (u + 0x7fffu + ((u >> 16) & 1u)) >> 16; }
__device__ __forceinline__ unsigned pk2(float lo, float hi) { return f2bf(lo) | (f2bf(hi) << 16); }
__device__ __forceinline__ float bf_lo(unsigned w) { return __uint_as_float(w << 16); }
__device__ __forceinline__ float bf_hi(unsigned w) { return __uint_as_float(w & 0xffff0000u); }
__device__ __forceinline__ float wave_sum(float v) {
#pragma unroll
    for (int o = 1; o < 64; o <<= 1) v += __shfl_xor(v, o);
    return v;
}
__device__ __forceinline__ f32x4 mfma16(bf16x8 a, bf16x8 b, f32x4 c) { return __builtin_amdgcn_mfma_f32_16x16x32_bf16(a, b, c, 0, 0, 0); }
__device__ __forceinline__ bf16x8 ldfrag(const bf16* p) { return *(const bf16x8*)p; }
__device__ __forceinline__ bf16x8 pack8(f32x4 a, f32x4 b) { u32x4 w; w.x = pk2(a[0], a[1]); w.y = pk2(a[2], a[3]); w.z = pk2(b[0], b[1]); w.w = pk2(b[2], b[3]); return __builtin_bit_cast(bf16x8, w); }
__device__ __forceinline__ float sigmoidf_(float x) { return __builtin_amdgcn_rcpf(1.f + __expf(-x)); }
#define LDS_WAIT() asm volatile("s_waitcnt lgkmcnt(0)" ::: "memory")
namespace pg8 {
#define PG8_LAS __attribute__((address_space(3)))
typedef unsigned short bf16_t;
typedef short bf16x8 __attribute__((ext_vector_type(8)));
typedef float f32x4 __attribute__((ext_vector_type(4)));
typedef unsigned u32x4 __attribute__((ext_vector_type(4)));
constexpr int BM = 256, BK = 64, HALF = 128, HTB = HALF * BK * 2  , STAGE_BYTES = 8 * HTB, NXCD = 8, WGM = 8;

__host__ __device__ __forceinline__ int lds_byte(int r, int c) { const int st = (r >> 4) * 2 + (c >> 5), rr = r & 15, cc = c & 31, ob = rr * 64 + cc * 2; return st * 1024 + (ob ^ (((ob >> 9) & 1) << 5)); }
__host__ __device__ __forceinline__ void stage_rc(int b, int& R, int& C) { const int st = b / 1024, sb = b % 1024, swz = sb ^ (((sb >> 9) & 1) << 5); R = (st >> 1) * 16 + swz / 64; C = (st & 1) * 32 + (swz % 64) / 2; }
__host__ __device__ __forceinline__ int perm32(int rho) { const int n = rho >> 4, i = rho & 15; return 8 * (i >> 2) + 4 * n + (i & 3); }

struct Unit { int pm, pn, half; };
struct Gemm { const bf16_t* A; const bf16_t* Bt; int M, N, K; const bf16_t* A2; const bf16_t* Bt2; };

struct StaticOrder {
    int nM, nN, nwg, G, c;
    __host__ __device__ void init(int M, int N, int G_, int c_) { nM = M / BM; nN = N / BM; nwg = nM * nN; G = G_; c = c_; }
    __host__ __device__ bool next(int i, Unit& u) const {
        const long L = (long)i * G + c; if (L >= nwg) return false;
        int wgid = (int)L; { const int q = nwg / NXCD, r = nwg % NXCD, xcd = wgid % NXCD, off = wgid / NXCD; wgid = (xcd < r ? xcd * (q + 1) : r * (q + 1) + (xcd - r) * q) + off; }
        const int nig = WGM * nN, gid = wgid / nig, fm = gid * WGM, gsz = (nM - fm) < WGM ? (nM - fm) : WGM;
        u.pm = fm + ((wgid % nig) % gsz); u.pn = (wgid % nig) / gsz; return true;
    }
    __device__ __forceinline__ void a_ready(const Unit&) const {}
    __device__ __forceinline__ void done(const Unit&) const {}
};
struct PairOrder {
    StaticOrder S;
    __host__ __device__ bool next(int i, Unit& u) const { if (!S.next(i >> 1, u)) return false; u.half = i & 1; return true; }
    __device__ __forceinline__ void a_ready(const Unit&) const {}
    __device__ __forceinline__ void done(const Unit&) const {}
};

__device__ __forceinline__ unsigned cvt_pk_bf16(float lo, float hi) { unsigned r; asm volatile("v_cvt_pk_bf16_f32 %0, %1, %2" : "=v"(r) : "v"(lo), "v"(hi)); return r; }
typedef float f32x2 __attribute__((ext_vector_type(2)));
__device__ __forceinline__ f32x2 gelu_pk(f32x2 v) {
    const f32x2 av = __builtin_elementwise_abs(v), d = av * 0.2316418882f + 1.0f;
    f32x2 t; t.x = __builtin_amdgcn_rcpf(d.x); t.y = __builtin_amdgcn_rcpf(d.y);
    f32x2 q = t * 0.5307027145f + (-0.7265760135f); q = q * t + 0.7107068705f; q = q * t + (-0.142248368f); q = q * t + 0.127414796f; q = q * t;
    const f32x2 s = (v * v) * (-0.72134752044f);
    f32x2 e; e.x = __builtin_amdgcn_exp2f(s.x); e.y = __builtin_amdgcn_exp2f(s.y);
    const f32x2 m = v * (q * e), r = v - m;
    f32x2 o; o.x = v.x < 0.f ? m.x : r.x; o.y = v.y < 0.f ? m.y : r.y; return o;
}

template <int ACT  > struct EpiBf16 {
    static constexpr bool PERM = true, AFTER_DRAIN = false, PAIR = false; static_assert(ACT == 0 || ACT == 1, "EpiBf16: ACT is 0 (none) or 1 (gelu_pk)");
    bf16_t* O; int ldc; const float* bias; int split_cols; size_t split_stride; float scale0;
    __device__ __forceinline__ void operator()(const f32x4 (&acc)[2][2][4][2], const Unit& u, int wr, int wc, int fr, int fq) const {
        const int row0 = u.pm * BM + wr * 64 + fr; int colt = u.pn * BM; bf16_t* base = O;
        float sc = 1.f; if (split_cols) { const int t = colt / split_cols; base += (size_t)t * split_stride; colt -= t * split_cols; if (t == 0) sc = scale0; }
        const int col0 = colt + wc * 32 + 8 * fq, bcol0 = u.pn * BM + wc * 32 + 8 * fq;
        f32x4 bv[2][2];
#pragma unroll
        for (int bj = 0; bj < 2; ++bj)
#pragma unroll
            for (int n = 0; n < 2; ++n) bv[bj][n] = bias ? *(const f32x4*)(bias + bcol0 + bj * HALF + 4 * n) : (f32x4){0.f, 0.f, 0.f, 0.f};
#pragma unroll
        for (int ai = 0; ai < 2; ++ai)
#pragma unroll
            for (int m = 0; m < 4; ++m) { bf16_t* rowp = base + (size_t)(row0 + ai * HALF + m * 16) * ldc + col0;
#pragma unroll
                for (int bj = 0; bj < 2; ++bj) { f32x4 v0 = acc[ai][bj][m][0] + bv[bj][0], v1 = acc[ai][bj][m][1] + bv[bj][1];
                    if (ACT == 1) { f32x2 a = gelu_pk((f32x2){v0[0], v0[1]}), b = gelu_pk((f32x2){v0[2], v0[3]}), c = gelu_pk((f32x2){v1[0], v1[1]}), d = gelu_pk((f32x2){v1[2], v1[3]});
                        v0 = (f32x4){a.x, a.y, b.x, b.y}; v1 = (f32x4){c.x, c.y, d.x, d.y}; }
                    v0 = v0 * sc; v1 = v1 * sc; u32x4 w; w.x = cvt_pk_bf16(v0[0], v0[1]); w.y = cvt_pk_bf16(v0[2], v0[3]); w.z = cvt_pk_bf16(v1[0], v1[1]); w.w = cvt_pk_bf16(v1[2], v1[3]);
                    *(u32x4*)(rowp + bj * HALF) = w; } }
    }
};
template <class Epi, class Sched, bool ALIGN_EPI = false, bool SP2 = false>
__device__ __forceinline__ void gemm_phase(PG8_LAS unsigned char* lds, const Gemm g, const Sched& S, const Epi& E) {
    const int tid = threadIdx.x, wid = __builtin_amdgcn_readfirstlane(tid >> 6), lane = tid & 63, wr = wid >> 2, wc = wid & 3, fr = lane & 15, fq = lane >> 4;
    const int K = g.K, nt = K / BK;
    unsigned voffA[2], voffB[2];
#pragma unroll
    for (int i = 0; i < 2; ++i) { int R, C; stage_rc(tid * 16 + i * 8192, R, C); const int Rb = Epi::PERM ? ((R & ~31) + perm32(R & 31)) : R;
        voffA[i] = (unsigned)(R * K + C) * 2u; voffB[i] = (unsigned)(Rb * K + C) * 2u; }
    const size_t kstep = (size_t)(BK * 2);
    const size_t hstep = (size_t)HALF * K * 2;
    const size_t tstep = 2 * hstep;
    const unsigned ldsw = (unsigned)wid * 1024u;
    const int aoff = lds_byte(wr * 64 + fr, fq * 8), boff = lds_byte(wc * 32 + fr, fq * 8);
#define PG8_SA(b, h) (((b) * 2 + (h)) * HTB)
#define PG8_SB(b, h) ((4 + (b) * 2 + (h)) * HTB)
#define PG8_STAGE(bufoff, gbase, voff) do { _Pragma("unroll") for (int _i = 0; _i < 2; ++_i) \
        __builtin_amdgcn_global_load_lds((const unsigned*)((const char*)(gbase) + (voff)[_i]), (PG8_LAS unsigned*)(lds + (bufoff) + ldsw + _i * 8192), 16, 0, 0); } while (0)
#define PG8_LDA(dst, b, h) do { _Pragma("unroll") for (int m = 0; m < 4; ++m) _Pragma("unroll") for (int k = 0; k < 2; ++k) dst[m][k] = *(const PG8_LAS bf16x8*)(lds + PG8_SA(b, h) + aoff + m * 2048 + k * 1024); } while (0)
#define PG8_LDB(dst, b, h) do { _Pragma("unroll") for (int n = 0; n < 2; ++n) _Pragma("unroll") for (int k = 0; k < 2; ++k) dst[n][k] = *(const PG8_LAS bf16x8*)(lds + PG8_SB(b, h) + boff + n * 2048 + k * 1024); } while (0)
#define PG8_MMA(ai, bj, At, Bt) do { __builtin_amdgcn_s_setprio(1); _Pragma("unroll") for (int m = 0; m < 4; ++m) _Pragma("unroll") for (int n = 0; n < 2; ++n) _Pragma("unroll") for (int k = 0; k < 2; ++k) \
        acc[ai][bj][m][n] = __builtin_amdgcn_mfma_f32_16x16x32_bf16(Bt[n][k], At[m][k], acc[ai][bj][m][n], 0, 0, 0); __builtin_amdgcn_s_setprio(0); } while (0)
#define PG8_WAIT_V(n) asm volatile("s_waitcnt vmcnt(" #n ")" ::: "memory")
#define PG8_WAIT_L(n) asm volatile("s_waitcnt lgkmcnt(" #n ")" ::: "memory")
#define PG8_BAR __builtin_amdgcn_s_barrier()
#define PG8_SCHED __builtin_amdgcn_sched_barrier(0)
    Unit cur, nxt; int ui = 0;
    if (!S.next(0, cur)) return;
    f32x4 acc[2][2][4][2];
#pragma unroll
    for (int a = 0; a < 2; ++a)
#pragma unroll
        for (int b = 0; b < 2; ++b)
#pragma unroll
            for (int m = 0; m < 4; ++m)
#pragma unroll
                for (int n = 0; n < 2; ++n) acc[a][b][m][n] = (f32x4){0.f, 0.f, 0.f, 0.f};
    bf16x8 At[4][2], B0[2][2], B1[2][2];
    const char* cA; const char* cB;
    if constexpr (Epi::PAIR) { cA = (const char*)(cur.half ? g.A2 : g.A) + (size_t)cur.pm * tstep; cB = (const char*)(cur.half ? g.Bt2 : g.Bt) + (size_t)cur.pn * tstep; }
    else { cA = (const char*)g.A + (size_t)cur.pm * tstep; cB = (const char*)g.Bt + (size_t)cur.pn * tstep; }
    S.a_ready(cur);
    if constexpr (SP2) {
        PG8_STAGE(PG8_SB(0, 0), cB, voffB); PG8_STAGE(PG8_SB(0, 1), cB + hstep, voffB); PG8_STAGE(PG8_SA(0, 0), cA, voffA); PG8_STAGE(PG8_SA(0, 1), cA + hstep, voffA);
        if (wr == 1) PG8_BAR;
        PG8_WAIT_V(2); PG8_BAR;
        PG8_STAGE(PG8_SB(1, 0), cB + kstep, voffB); PG8_STAGE(PG8_SA(1, 0), cA + kstep, voffA); PG8_STAGE(PG8_SB(1, 1), cB + hstep + kstep, voffB);
        PG8_WAIT_V(6); PG8_BAR;
    } else {
        PG8_STAGE(PG8_SB(0, 0), cB, voffB); PG8_STAGE(PG8_SA(0, 0), cA, voffA); PG8_STAGE(PG8_SB(0, 1), cB + hstep, voffB); PG8_STAGE(PG8_SA(0, 1), cA + hstep, voffA);
        if (wr == 1) PG8_BAR;
        PG8_WAIT_V(4); PG8_BAR;
        PG8_STAGE(PG8_SB(1, 0), cB + kstep, voffB); PG8_STAGE(PG8_SA(1, 0), cA + kstep, voffA); PG8_STAGE(PG8_SB(1, 1), cB + hstep + kstep, voffB);
        PG8_WAIT_V(6); PG8_BAR;
    }
    for (;;) {
        const bool has_next = S.next(ui + 1, nxt);
        const char* nA; const char* nB;
        if constexpr (Epi::PAIR) { nA = has_next ? (const char*)(nxt.half ? g.A2 : g.A) + (size_t)nxt.pm * tstep : cA; nB = has_next ? (const char*)(nxt.half ? g.Bt2 : g.Bt) + (size_t)nxt.pn * tstep : cB; }
        else { nA = has_next ? (const char*)g.A + (size_t)nxt.pm * tstep : cA; nB = has_next ? (const char*)g.Bt + (size_t)nxt.pn * tstep : cB; }
        for (int t = 0; t < nt; t += 2) {
            const bool last = (t == nt - 2);
            const char* a1 = cA + (size_t)(t + 1) * kstep;
            const char* a2 = last ? nA : cA + (size_t)(t + 2) * kstep; const char* b2 = last ? nB : cB + (size_t)(t + 2) * kstep;
            const char* a3 = a2 + kstep; const char* b3 = b2 + kstep;
            if (last && has_next) S.a_ready(nxt);
            if constexpr (SP2) {
            PG8_LDB(B0, 0, 0); PG8_LDB(B1, 0, 1); PG8_SCHED; PG8_LDA(At, 0, 0); PG8_STAGE(PG8_SA(1, 1), a1 + hstep, voffA);
            PG8_WAIT_V(8); PG8_WAIT_L(0); PG8_BAR; PG8_MMA(0, 0, At, B0); PG8_MMA(0, 1, At, B1); PG8_BAR; PG8_SCHED;
            PG8_LDA(At, 0, 1); PG8_STAGE(PG8_SB(0, 0), b2, voffB); PG8_STAGE(PG8_SB(0, 1), b2 + hstep, voffB); PG8_STAGE(PG8_SA(0, 0), a2, voffA);
            PG8_WAIT_V(8); PG8_WAIT_L(0); PG8_BAR; PG8_MMA(1, 0, At, B0); PG8_MMA(1, 1, At, B1); PG8_BAR; PG8_SCHED;
            PG8_LDB(B0, 1, 0); PG8_LDB(B1, 1, 1); PG8_SCHED; PG8_LDA(At, 1, 0); PG8_STAGE(PG8_SA(0, 1), a2 + hstep, voffA);
            PG8_WAIT_V(8); PG8_WAIT_L(0); PG8_BAR; PG8_MMA(0, 0, At, B0); PG8_MMA(0, 1, At, B1); PG8_BAR; PG8_SCHED;
            PG8_LDA(At, 1, 1); PG8_STAGE(PG8_SB(1, 0), b3, voffB); PG8_STAGE(PG8_SB(1, 1), b3 + hstep, voffB); PG8_STAGE(PG8_SA(1, 0), a3, voffA);
            PG8_WAIT_V(8); PG8_WAIT_L(0); PG8_BAR; PG8_MMA(1, 0, At, B0); PG8_MMA(1, 1, At, B1); PG8_BAR; PG8_SCHED;
            } else {
            PG8_LDB(B0, 0, 0); PG8_SCHED; PG8_LDA(At, 0, 0); PG8_STAGE(PG8_SA(1, 1), a1 + hstep, voffA);
            PG8_WAIT_L(8); PG8_BAR; PG8_WAIT_L(0); PG8_MMA(0, 0, At, B0); PG8_BAR; PG8_SCHED;
            PG8_LDB(B1, 0, 1); PG8_STAGE(PG8_SB(0, 0), b2, voffB);
            PG8_BAR; PG8_WAIT_L(0); PG8_MMA(0, 1, At, B1); PG8_BAR;
            PG8_LDA(At, 0, 1); PG8_STAGE(PG8_SA(0, 0), a2, voffA);
            PG8_BAR; PG8_WAIT_L(0); PG8_MMA(1, 0, At, B0); PG8_BAR; PG8_SCHED;
            PG8_STAGE(PG8_SB(0, 1), b2 + hstep, voffB);
            PG8_WAIT_V(6); PG8_BAR; PG8_MMA(1, 1, At, B1); PG8_BAR;
            PG8_LDB(B0, 1, 0); PG8_SCHED; PG8_LDA(At, 1, 0); PG8_STAGE(PG8_SA(0, 1), a2 + hstep, voffA);
            PG8_WAIT_L(8); PG8_BAR; PG8_WAIT_L(0); PG8_MMA(0, 0, At, B0); PG8_BAR; PG8_SCHED;
            PG8_LDB(B1, 1, 1); PG8_STAGE(PG8_SB(1, 0), b3, voffB);
            PG8_BAR; PG8_WAIT_L(0); PG8_MMA(0, 1, At, B1); PG8_BAR;
            PG8_LDA(At, 1, 1); PG8_STAGE(PG8_SA(1, 0), a3, voffA);
            PG8_BAR; PG8_WAIT_L(0); PG8_MMA(1, 0, At, B0); PG8_BAR; PG8_SCHED;
            PG8_STAGE(PG8_SB(1, 1), b3 + hstep, voffB);
            PG8_WAIT_V(6); PG8_BAR; PG8_MMA(1, 1, At, B1); PG8_BAR;
            }
        }
        if constexpr (ALIGN_EPI) { if (wr == 0) PG8_BAR; }
        if constexpr (Epi::PAIR) { if (cur.half == 0) E.mid(acc, cur, wr, wc, fr, fq); else E(acc, cur, wr, wc, fr, fq); }
        else if constexpr (!Epi::AFTER_DRAIN) { E(acc, cur, wr, wc, fr, fq); S.done(cur); }
        if (!has_next) break;
        if (!(Epi::PAIR && cur.half == 0))
#pragma unroll
        for (int a = 0; a < 2; ++a)
#pragma unroll
            for (int b = 0; b < 2; ++b)
#pragma unroll
                for (int m = 0; m < 4; ++m)
#pragma unroll
                    for (int n = 0; n < 2; ++n) acc[a][b][m][n] = (f32x4){0.f, 0.f, 0.f, 0.f};
        cur = nxt; cA = nA; cB = nB; ++ui;
        if constexpr (ALIGN_EPI) { if (wr == 1) PG8_BAR; }
    }
    PG8_WAIT_V(0);
    if constexpr (!ALIGN_EPI) { if (wr == 0) PG8_BAR; }
    PG8_BAR;
    if constexpr (Epi::AFTER_DRAIN) { E.fused(acc, cur, wr, wc, fr, fq, lds, wid, lane); S.done(cur); }
#undef PG8_SA
#undef PG8_SB
#undef PG8_STAGE
#undef PG8_LDA
#undef PG8_LDB
#undef PG8_MMA
#undef PG8_WAIT_V
#undef PG8_WAIT_L
#undef PG8_BAR
#undef PG8_SCHED
}
}
typedef GAS unsigned gu32;
#define RLX_AGENT __ATOMIC_RELAXED, __HIP_MEMORY_SCOPE_AGENT
#define XB_TMO      128
#define XB_XCNT(j)  (256  + 64 * (j))
#define XB_XSUB(j)  (1280 + 64 * (j))
#define XB_XGEN(j)  (2304 + 64 * (j))
#define XB_TOP      3328
#define XB_TOPGEN   3392
#define XCD_BAR_WORDS 3456
#define XB_SPIN_CAP (1u << 18)

__device__ __forceinline__ unsigned xb_ld(unsigned* p)              { return __hip_atomic_load(p, __ATOMIC_RELAXED, __HIP_MEMORY_SCOPE_AGENT); }
__device__ __forceinline__ unsigned xb_add(unsigned* p, unsigned v) { return __hip_atomic_fetch_add(p, v, __ATOMIC_RELAXED, __HIP_MEMORY_SCOPE_AGENT); }
__device__ __forceinline__ unsigned xb_xcc_id() { return (unsigned)__builtin_amdgcn_s_getreg((3 << 11) | 20) & 0xFu; }
#define XB_SPIN(cond, bar) do { unsigned _sp = 0; while (cond) { __builtin_amdgcn_s_sleep(1); \
    if ((++_sp & 255u) == 0u) { if (xb_ld(&(bar)[XB_TMO])) break; if (_sp > XB_SPIN_CAP) { atomicAdd(&(bar)[XB_TMO], 1u); break; } } } } while (0)

struct XcdBarrier {
    unsigned* bar; unsigned x;
    volatile LAS unsigned* st;
};

__device__ __forceinline__ XcdBarrier xcd_barrier_post(unsigned* bar, volatile LAS unsigned* st) {
    XcdBarrier b; b.bar = bar; b.x = xb_xcc_id(); b.st = st;
    if (threadIdx.x == 0) (void)xb_add(&bar[XB_XCNT(b.x)], 1u);
    return b;
}
__device__ __forceinline__ void xcd_barrier_complete(unsigned* bar, unsigned x, unsigned& nloc, unsigned& nx) {
    const unsigned G = gridDim.x * gridDim.y * gridDim.z;
    unsigned sum, cnt, mine, sp = 0u;
    for (;;) {
        sum = 0u; cnt = 0u; mine = 0u;
#pragma unroll
        for (unsigned j = 0; j < 16; ++j) { const unsigned c = xb_ld(&bar[XB_XCNT(j)]); sum += c; cnt += (c > 0u) ? 1u : 0u; mine = (j == x) ? c : mine; }
        if (sum == G) break;
        __builtin_amdgcn_s_sleep(1);
        if ((++sp & 255u) == 0u) { if (xb_ld(&bar[XB_TMO])) break; if (sp > XB_SPIN_CAP) { atomicAdd(&bar[XB_TMO], 1u); break; } }
    }
    nloc = mine > 0u ? mine : 1u; nx = cnt > 0u ? cnt : 1u;
}

__device__ __forceinline__ void xcd_barrier(const XcdBarrier& b) {
    asm volatile("s_waitcnt vmcnt(0)" ::: "memory");
    __syncthreads();
    if (threadIdx.x == 0) {
        unsigned* bar = b.bar;
        __builtin_amdgcn_s_waitcnt(0);
        unsigned nloc = b.st[0], nx = b.st[1];
        if (nloc == 0u) { xcd_barrier_complete(bar, b.x, nloc, nx); b.st[0] = nloc; b.st[1] = nx; }
        const unsigned old = xb_add(&bar[XB_XSUB(b.x)], 1u);
        const unsigned gen = old / nloc;
        if (old + 1u == (gen + 1u) * nloc) {
            __builtin_amdgcn_fence(__ATOMIC_RELEASE, "agent");
            asm volatile("s_waitcnt vmcnt(0)" ::: "memory");
            const unsigned og = xb_add(&bar[XB_TOP], 1u);
            const unsigned tg = og / nx;
            if (og + 1u == (tg + 1u) * nx) xb_add(&bar[XB_TOPGEN], 1u);
            else XB_SPIN(xb_ld(&bar[XB_TOPGEN]) == tg, bar);
            __builtin_amdgcn_fence(__ATOMIC_ACQUIRE, "agent");
            xb_add(&bar[XB_XGEN(b.x)], 1u);
            asm volatile("s_waitcnt vmcnt(0)" ::: "memory");
        } else {
            XB_SPIN(xb_ld(&bar[XB_XGEN(b.x)]) == gen, bar);
            __builtin_amdgcn_fence(__ATOMIC_ACQUIRE, "agent");
            asm volatile("s_waitcnt vmcnt(0)" ::: "memory");
        }
    }
    __syncthreads();
}
struct EpiStd {
    static constexpr bool PERM = true, AFTER_DRAIN = false, PAIR = false;
    bf16* P1; const float* rope; float* kp; float* ks;
    __device__ __forceinline__ void operator()(const pg8::f32x4 (&acc)[2][2][4][2], const pg8::Unit& u, int wr, int wc, int fr, int fq) const {
        const int blk = u.pn >> 1;
        const bool do_rope = (blk <= 1) && ((wc & 1) == 0);
        const float scale = blk == 0 ? 0.125f : (blk == 4 ? 0.08838834764831845f : 1.f);
        const int row0 = u.pm * 256 + wr * 64 + fr, colw = u.pn * 256 + wc * 32 + 8 * fq;
#pragma unroll
        for (int ai = 0; ai < 2; ++ai)
#pragma unroll
            for (int m = 0; m < 4; ++m) {
                const int r = row0 + ai * 128 + m * 16;
                f32x4 cs0 = {1.f, 1.f, 1.f, 1.f}, cs1 = cs0, sn0 = {0.f, 0.f, 0.f, 0.f}, sn1 = sn0;
                if (do_rope) { const int pi = r < NP ? r : NP + ((r - NP) & 7); const f32x4* rp = (const f32x4*)(rope + (size_t)pi * 16); cs0 = rp[0]; cs1 = rp[1]; sn0 = rp[2]; sn1 = rp[3]; }
#pragma unroll
                for (int bj = 0; bj < 2; ++bj) {
                    f32x4 v0 = acc[ai][bj][m][0], v1 = acc[ai][bj][m][1];
                    if (do_rope) {
                        f32x4 p0, p1;
#pragma unroll
                        for (int e = 0; e < 4; ++e) { p0[e] = __shfl_xor(v0[e], 16); p1[e] = __shfl_xor(v1[e], 16); }
                        if (fq == 0) { v0 = v0 * cs0 - p0 * sn0; v1 = v1 * cs1 - p1 * sn1; }
                        else if (fq == 1) { v0 = p0 * sn0 + v0 * cs0; v1 = p1 * sn1 + v1 * cs1; }
                    }
                    v0 = v0 * scale; v1 = v1 * scale;
                    u32x4 w; w.x = pg8::cvt_pk_bf16(v0[0], v0[1]); w.y = pg8::cvt_pk_bf16(v0[2], v0[3]); w.z = pg8::cvt_pk_bf16(v1[0], v1[1]); w.w = pg8::cvt_pk_bf16(v1[2], v1[3]);
                    *(u32x4*)(P1 + (size_t)r * P1W + colw + bj * 128) = w;
                    if (blk == 1 && r >= NP - 2048) {
                        const int col = colw + bj * 128 - C_AK;
                        float* dst = (r < NP ? kp + (size_t)(r - (NP - 2048)) * 512 : ks + (size_t)(r - NP) * 512) + col;
                        *(f32x4*)dst = v0; *(f32x4*)(dst + 4) = v1;
                    }
                }
            }
    }
};
struct EpiTr {
    static constexpr bool PERM = true, AFTER_DRAIN = false, PAIR = false;
    bf16* PT; float* vp; float* vs;
    __device__ __forceinline__ void operator()(const pg8::f32x4 (&acc)[2][2][4][2], const pg8::Unit& u, int wr, int wc, int fr, int fq) const {
        const int blk = u.pm >> 1;
        const int f0 = u.pm * 256 + wr * 64 + fr, tok0 = u.pn * 256 + wc * 32 + 8 * fq;
        const bool vout = (blk == 1) && (u.pn >= (NP - 2048) / 256);
#pragma unroll
        for (int ai = 0; ai < 2; ++ai)
#pragma unroll
            for (int m = 0; m < 4; ++m) {
                const int f = f0 + ai * 128 + m * 16;
#pragma unroll
                for (int bj = 0; bj < 2; ++bj) {
                    const int tk = tok0 + bj * 128;
                    const f32x4 v0 = acc[ai][bj][m][0], v1 = acc[ai][bj][m][1];
                    u32x4 w; w.x = pg8::cvt_pk_bf16(v0[0], v0[1]); w.y = pg8::cvt_pk_bf16(v0[2], v0[3]); w.z = pg8::cvt_pk_bf16(v1[0], v1[1]); w.w = pg8::cvt_pk_bf16(v1[2], v1[3]);
                    *(u32x4*)(PT + (size_t)f * MT + tk) = w;
                    if (vout) {
                        const int vf = f - R_AVT;
                        float* dst = (tk < NP ? vp + (size_t)(tk - (NP - 2048)) * 512 : vs + (size_t)(tk - NP) * 512) + vf;
#pragma unroll
                        for (int e = 0; e < 4; ++e) { dst[(size_t)e * 512] = v0[e]; dst[(size_t)(e + 4) * 512] = v1[e]; }
                    }
                }
            }
    }
};
struct EpiX1P {
    static constexpr bool PERM = true, AFTER_DRAIN = false, PAIR = true;
    const float* xp; const float* xs; const float* mod; const float* SSA; const float* SSM; float* x1;
    __device__ __forceinline__ void mid(pg8::f32x4 (&acc)[2][2][4][2], const pg8::Unit& u, int wr, int wc, int fr, int fq) const {
        const int row0 = u.pm * 256 + wr * 64 + fr;
#pragma unroll
        for (int ai = 0; ai < 2; ++ai)
#pragma unroll
            for (int m = 0; m < 4; ++m) {
                const int r = row0 + ai * 128 + m * 16;
                const f32x4 a0 = *(const f32x4*)(SSA + (size_t)r * 8), a1 = *(const f32x4*)(SSA + (size_t)r * 8 + 4), m0 = *(const f32x4*)(SSM + (size_t)r * 4);
                const float ssa = ((a0[0] + a0[1]) + (a0[2] + a0[3])) + ((a1[0] + a1[1]) + (a1[2] + a1[3])), ssm = (m0[0] + m0[1]) + (m0[2] + m0[3]);
                const float ratio = __builtin_amdgcn_rsqf(ssa * (1.f / 512.f) + EPS) * __builtin_amdgcn_sqrtf(ssm * (1.f / 512.f) + EPS);
#pragma unroll
                for (int bj = 0; bj < 2; ++bj) { acc[ai][bj][m][0] = acc[ai][bj][m][0] * ratio; acc[ai][bj][m][1] = acc[ai][bj][m][1] * ratio; }
            }
    }
    __device__ __forceinline__ void operator()(const pg8::f32x4 (&acc)[2][2][4][2], const pg8::Unit& u, int wr, int wc, int fr, int fq) const {
        const int row0 = u.pm * 256 + wr * 64 + fr, colw = u.pn * 256 + wc * 32 + 8 * fq;
#pragma unroll
        for (int ai = 0; ai < 2; ++ai)
#pragma unroll
            for (int m = 0; m < 4; ++m) {
                const int r = row0 + ai * 128 + m * 16;
                const int brow = r < NP ? 0 : 1 + ((r - NP) >> 3);
                const float* gt = mod + (size_t)brow * 6144 + 2048;
                const f32x4 s4 = *(const f32x4*)(SSM + (size_t)r * 4);
                const float ss = (s4[0] + s4[1]) + (s4[2] + s4[3]);
                const float rstd = 1.0f / sqrtf(ss * (1.f / 512.f) + EPS);
                const float* base = r < NP ? xp + (size_t)r * DM : xs + (size_t)(r - NP) * DM;
#pragma unroll
                for (int bj = 0; bj < 2; ++bj) {
                    const int col = colw + bj * 128;
                    const f32x4 x0 = *(const f32x4*)(base + col), x1v = *(const f32x4*)(base + col + 4), g0 = *(const f32x4*)(gt + col) * rstd, g1 = *(const f32x4*)(gt + col + 4) * rstd;
                    *(f32x4*)(x1 + (size_t)r * DM + col) = x0 + g0 * acc[ai][bj][m][0];
                    *(f32x4*)(x1 + (size_t)r * DM + col + 4) = x1v + g1 * acc[ai][bj][m][1];
                }
            }
    }
};
__device__ __forceinline__ void p0_transpose_item(const float* W, int ldw, int col0, int K, bf16* WT, int row_off, const float* kscale, LAS float* scr, int item, int nblk, int lane) {
    const int kb = item / nblk, nb = item % nblk, k0 = 64 * kb, n0 = 32 * nb;
    float tv[32];
#pragma unroll
    for (int i = 0; i < 32; ++i) { const int kk = 2 * i + (lane >> 5); tv[i] = W[(size_t)(k0 + kk) * ldw + col0 + n0 + (lane & 31)]; }
#pragma unroll
    for (int i = 0; i < 32; ++i) { const int kk = 2 * i + (lane >> 5); float v = tv[i]; if (kscale) v *= kscale[k0 + kk]; scr[kk * 33 + (lane & 31)] = v; }
    LDS_WAIT(); asm volatile("" ::: "memory");
    const int c = lane & 7;
#pragma unroll
    for (int j = 0; j < 4; ++j) { const int n = (lane >> 3) + 8 * j; const LAS float* s = scr + (8 * c) * 33 + n;
        u32x4 o; o.x = pk2(s[0 * 33], s[1 * 33]); o.y = pk2(s[2 * 33], s[3 * 33]); o.z = pk2(s[4 * 33], s[5 * 33]); o.w = pk2(s[6 * 33], s[7 * 33]);
        *(u32x4*)(WT + (size_t)(row_off + n0 + n) * K + k0 + 8 * c) = o; }
    LDS_WAIT(); asm volatile("" ::: "memory");
}
__device__ __forceinline__ void cvt512h(const float* src, bf16* dst, int lane) {
    const f32x4 a = *(const f32x4*)(src + 8 * lane), b = *(const f32x4*)(src + 8 * lane + 4);
    typedef _Float16 hv2 __attribute__((ext_vector_type(2)));
    u32x4 w; hv2 t;
    t[0] = (_Float16)a[0]; t[1] = (_Float16)a[1]; w.x = __builtin_bit_cast(unsigned, t); t[0] = (_Float16)a[2]; t[1] = (_Float16)a[3]; w.y = __builtin_bit_cast(unsigned, t);
    t[0] = (_Float16)b[0]; t[1] = (_Float16)b[1]; w.z = __builtin_bit_cast(unsigned, t); t[0] = (_Float16)b[2]; t[1] = (_Float16)b[3]; w.w = __builtin_bit_cast(unsigned, t);
    *(u32x4*)(dst + 8 * lane) = w;
}
__device__ __forceinline__ void cvt512(const float* src, bf16* dst, int lane) {
    const f32x4 a = *(const f32x4*)(src + 8 * lane), b = *(const f32x4*)(src + 8 * lane + 4);
    u32x4 w; w.x = pk2(a[0], a[1]); w.y = pk2(a[2], a[3]); w.z = pk2(b[0], b[1]); w.w = pk2(b[2], b[3]);
    *(u32x4*)(dst + 8 * lane) = w;
}
__device__ __forceinline__ void prep_weights_late(const Args& a, LAS unsigned char* lds, int wave, int lane, int widx, int nwork) {
    unsigned char* ws = a.ws;
    LAS float* scr = (LAS float*)(lds + wave * 16384);
    bf16* WoutT = (bf16*)(ws + WS_WOUT); bf16* WpqT = (bf16*)(ws + WS_WPQ); bf16* KEYS = (bf16*)(ws + WS_KEYS);
    for (int it = widx; it < 512 + 1024 + 512; it += nwork) {
        int r = it;
        if (r < 512) { const int hf = r >> 8;
            p0_transpose_item(a.in[15] + (size_t)hf * 512 * 1024, 1024, 0, 512, WoutT + (size_t)hf * 1024 * 512, 0, a.in[14] + hf * 512, scr, r & 255, 32, lane); continue; }
        r -= 512;
        if (r < 1024) { p0_transpose_item(a.in[17], 2048, 0, DM, WpqT, 0, nullptr, scr, r, 64, lane); continue; }
        r -= 1024;
        const int side = r >= 256 ? 1 : 0; if (side) r -= 256;
        const int h = r >> 5, rem = r & 31;
        cvt512(a.in[18 + side] + (size_t)h * 16384 + rem * 512, KEYS + (size_t)(h * 2 + side) * 16384 + rem * 512, lane);
    }
}
__device__ __forceinline__ void prep_tables(const Args& a, int lane, int widx, int nwork, int it_lo, int it_hi) {
    unsigned char* ws = a.ws;
    float* SCU = (float*)(ws + WS_CH) + 65536; float* SCV = (float*)(ws + WS_CH) + 131072;
    for (int it = it_lo + widx; it < it_hi; it += nwork) {
        const int tb = it >= 4096 ? 1 : 0; const int row0 = 4 * (it - tb * 4096);
        const float* src = a.in[20 + tb] + (size_t)row0 * DM + 16 * lane; unsigned char* dst = (unsigned char*)(ws + (tb ? WS_V : WS_U)) + (size_t)row0 * DM + 16 * lane;
        f32x4 v[4][4];
#pragma unroll
        for (int r = 0; r < 4; ++r)
#pragma unroll
            for (int q = 0; q < 4; ++q) v[r][q] = *(const f32x4*)(src + (size_t)r * DM + 4 * q);
#pragma unroll
        for (int r = 0; r < 4; ++r) {
            float am = 0.f;
#pragma unroll
            for (int q = 0; q < 4; ++q) am = fmaxf(fmaxf(am, fmaxf(fabsf(v[r][q][0]), fabsf(v[r][q][1]))), fmaxf(fabsf(v[r][q][2]), fabsf(v[r][q][3])));
#pragma unroll
            for (int o = 1; o < 64; o <<= 1) am = fmaxf(am, __shfl_xor(am, o));
            const float inv = am > 0.f ? 127.f / am : 0.f;
            u32x4 w;
#pragma unroll
            for (int q = 0; q < 4; ++q) { unsigned pk = 0;
#pragma unroll
                for (int e = 0; e < 4; ++e) pk |= ((unsigned)(int)rintf(v[r][q][e] * inv) & 0xffu) << (8 * e);
                w[q] = pk; }
            *(u32x4*)(dst + (size_t)r * DM) = w;
            if (lane == 0) (tb ? SCV : SCU)[row0 + r] = am * (1.f / 127.f);
        }
    }
}
__device__ __forceinline__ void phase0(const Args& a, LAS unsigned char* lds, int tid, int wave, int lane, int vcu, int G, int pmask) {
    unsigned char* ws = a.ws;
    float* mod = (float*)(ws + WS_MOD);
    {
        const float* cp = a.in[7]; const float* cs = a.in[8]; const float* wada = a.in[9]; const float* bada = a.in[10];
        LAS float* scr = (LAS float*)(lds + wave * 8704);
        LAS float* RED = (LAS float*)(lds + 81920);
        const int i16 = lane & 15, g = lane >> 4;
        for (int u = vcu; u < ((pmask & 1) ? 192 : 0); u += G) {
            const int n0 = 32 * u;
            f32x4 acc[2][9];
#pragma unroll
            for (int nt = 0; nt < 2; ++nt)
#pragma unroll
                for (int bt = 0; bt < 9; ++bt) acc[nt][bt] = (f32x4){0.f, 0.f, 0.f, 0.f};
#pragma unroll 1
            for (int ch = 0; ch < 2; ++ch) {
                const int k0 = 128 * wave + 64 * ch;
#pragma unroll 8
                for (int i = 0; i < 32; ++i) { const int kk = 2 * i + (lane >> 5); scr[kk * 33 + (lane & 31)] = wada[(size_t)(k0 + kk) * 6144 + n0 + (lane & 31)]; }
                LDS_WAIT(); asm volatile("" ::: "memory");
#pragma unroll
                for (int ks = 0; ks < 2; ++ks) {
                    bf16x8 ah[2], al[2];
#pragma unroll
                    for (int nt = 0; nt < 2; ++nt) { float v[8]; unsigned hb[8], lb[8];
#pragma unroll
                        for (int j = 0; j < 8; ++j) { v[j] = scr[(32 * ks + 8 * g + j) * 33 + 16 * nt + i16]; hb[j] = f2bf(v[j]); lb[j] = f2bf(v[j] - __uint_as_float(hb[j] << 16)); }
                        u32x4 wh, wl; wh.x = hb[0] | (hb[1] << 16); wh.y = hb[2] | (hb[3] << 16); wh.z = hb[4] | (hb[5] << 16); wh.w = hb[6] | (hb[7] << 16);
                        wl.x = lb[0] | (lb[1] << 16); wl.y = lb[2] | (lb[3] << 16); wl.z = lb[4] | (lb[5] << 16); wl.w = lb[6] | (lb[7] << 16);
                        ah[nt] = __builtin_bit_cast(bf16x8, wh); al[nt] = __builtin_bit_cast(bf16x8, wl); }
#pragma unroll
                    for (int bt = 0; bt < 9; ++bt) {
                        const int b = 16 * bt + i16; const int k = k0 + 32 * ks + 8 * g;
                        f32x4 c0 = {0.f, 0.f, 0.f, 0.f}, c1 = c0;
                        if (b < 129) { const float* cr = b == 0 ? cp + k : cs + (size_t)(b - 1) * DM + k; c0 = *(const f32x4*)cr; c1 = *(const f32x4*)(cr + 4); }
                        unsigned hb[8], lb[8];
#pragma unroll
                        for (int j = 0; j < 8; ++j) { const float c = j < 4 ? c0[j & 3] : c1[j & 3]; const float sv = c * __builtin_amdgcn_rcpf(1.f + __expf(-c)); hb[j] = f2bf(sv); lb[j] = f2bf(sv - __uint_as_float(hb[j] << 16)); }
                        u32x4 wh, wl; wh.x = hb[0] | (hb[1] << 16); wh.y = hb[2] | (hb[3] << 16); wh.z = hb[4] | (hb[5] << 16); wh.w = hb[6] | (hb[7] << 16);
                        wl.x = lb[0] | (lb[1] << 16); wl.y = lb[2] | (lb[3] << 16); wl.z = lb[4] | (lb[5] << 16); wl.w = lb[6] | (lb[7] << 16);
                        const bf16x8 bh = __builtin_bit_cast(bf16x8, wh), bl = __builtin_bit_cast(bf16x8, wl);
#pragma unroll
                        for (int nt = 0; nt < 2; ++nt) { acc[nt][bt] = mfma16(ah[nt], bh, acc[nt][bt]); acc[nt][bt] = mfma16(ah[nt], bl, acc[nt][bt]); acc[nt][bt] = mfma16(al[nt], bh, acc[nt][bt]); }
                    }
                }
                LDS_WAIT(); asm volatile("" ::: "memory");
            }
            __syncthreads();
            for (int r = 0; r < 2; ++r) {
                if ((wave >> 2) == r) {
                    LAS float* RG = (LAS float*)lds + (wave & 3) * (32 * 145);
#pragma unroll
                    for (int nt = 0; nt < 2; ++nt)
#pragma unroll
                        for (int bt = 0; bt < 9; ++bt)
#pragma unroll
                            for (int e = 0; e < 4; ++e) { LAS float* pp = RG + (16 * nt + 4 * g + e) * 145 + 16 * bt + i16; *pp = (r == 0 ? 0.f : *pp) + acc[nt][bt][e]; }
                }
                __syncthreads();
            }
            { const int n = tid & 31, bg = tid >> 5; const float bb = bada[n0 + n];
#pragma unroll
              for (int i = 0; i < 9; ++i) { const int b = bg * 9 + i; const LAS float* r0 = (const LAS float*)lds + n * 145 + b;
                  if (b < 129) mod[(size_t)b * 6144 + n0 + n] = ((r0[0] + r0[32 * 145]) + (r0[2 * 32 * 145] + r0[3 * 32 * 145])) + bb; } }
            __syncthreads();
        }
        __syncthreads();
    }
    const int gw = vcu * NWAVES + wave, NGW = G * NWAVES;
    {
        LAS float* scr = (LAS float*)(lds + wave * 16384);
        bf16* WinT = (bf16*)(ws + WS_WIN);
        for (int r = gw; r < ((pmask & 2) ? 7 * 256 : 0); r += NGW) {
            const int blk = r >> 8; const int src_col = blk == 0 ? 0 : blk == 1 ? 512 : blk == 2 ? 1536 : blk == 3 ? 3072 : blk == 4 ? 2048 : blk == 5 ? 2560 : 1024;
            p0_transpose_item(a.in[12], 3592, src_col, DM, WinT, 512 * blk, nullptr, scr, r & 255, 16, lane);
        }
    }
    float* rope = (float*)(ws + WS_ROPE);
    for (int i = vcu * NTHREADS + tid; i < ((pmask & 8) ? (NP + 8) * 8 : 0); i += G * NTHREADS) {
        const int pi = i >> 3, f = i & 7; const double pos = pi < NP ? (double)pi : (double)(8192 + (pi - NP));
        const double invf = f == 0 ? 1.0 : f == 1 ? 0.19392274474868576 : f == 2 ? 0.03760603093086393 : f == 3 ? 0.007292664737217109 : f == 4 ? 0.001414213562373095
                          : f == 5 ? 0.0002742481756762073 : f == 6 ? 5.318295896944988e-05 : 1.031338537721246e-05;
        const double ang = pos * invf;
        rope[(size_t)pi * 16 + f] = (float)cos(ang); rope[(size_t)pi * 16 + 8 + f] = (float)sin(ang);
    }
}
template <bool FIRST>
__device__ __forceinline__ void phase_norm(const Args& a, LAS unsigned char* lds, int tid, int wave, int lane, int vcu, int G) {
    unsigned char* ws = a.ws;
    const float* mod = (const float*)(ws + WS_MOD);
    const float* gvec = a.in[FIRST ? 11 : 16];
    bf16* H = (bf16*)(ws + WS_H);
    LAS float* WG = (LAS float*)lds;
    if (FIRST) {
        for (int i = tid; i < DM * 8; i += NTHREADS) WG[(i & 7) * DM + (i >> 3)] = a.in[12][(size_t)(i >> 3) * 3592 + 3584 + (i & 7)];
        __syncthreads();
    }
    const int sh_off = FIRST ? 0 : 3072, sc_off = FIRST ? 1024 : 4096;
    const int gw = vcu * NWAVES + wave, NGW = G * NWAVES;
    const int nit = G == 256 ? 5 : (MT + 2 * NGW - 1) / (2 * NGW);
    for (int it = 0; it < nit; ++it) {
        int rr[2];
#pragma unroll
        for (int k = 0; k < 2; ++k) { const int slot = 2 * it + k;
            rr[k] = G == 256 ? ((slot < 8 || (slot == 8 && wave < 4)) ? 68 * vcu + (slot < 8 ? wave + 8 * slot : 64 + wave) : MT) : gw + slot * NGW; }
        f32x4 vv[2][4];
#pragma unroll
        for (int k = 0; k < 2; ++k) { const int r = rr[k]; if (r < MT) {
            const float* xrow = FIRST ? (r < NP ? a.in[0] + (size_t)r * DM : a.in[1] + (size_t)(r - NP) * DM) : (const float*)(ws + WS_X1) + (size_t)r * DM;
#pragma unroll
            for (int j = 0; j < 4; ++j) vv[k][j] = *(const f32x4*)(xrow + 4 * lane + 256 * j); } }
#pragma unroll
        for (int k = 0; k < 2; ++k) { const int r = rr[k]; if (r < MT) {
        const int brow = r < NP ? 0 : 1 + ((r - NP) >> 3);
        const float* mrow = mod + (size_t)brow * 6144;
        float ss = 0.f;
#pragma unroll
        for (int j = 0; j < 4; ++j) ss += (vv[k][j][0] * vv[k][j][0] + vv[k][j][1] * vv[k][j][1]) + (vv[k][j][2] * vv[k][j][2] + vv[k][j][3] * vv[k][j][3]);
        const float rstd = 1.0f / sqrtf(wave_sum(ss) * (1.f / DM) + EPS);
        float gp[8];
#pragma unroll
        for (int e = 0; e < 8; ++e) gp[e] = 0.f;
#pragma unroll
        for (int j = 0; j < 4; ++j) {
            const int c = 4 * lane + 256 * j;
            const f32x4 g = *(const f32x4*)(gvec + c), sc = *(const f32x4*)(mrow + sc_off + c), sh = *(const f32x4*)(mrow + sh_off + c);
            f32x4 h = (vv[k][j] * rstd) * g * (sc + 1.0f) + sh;
            u32x2 w; w.x = pk2(h[0], h[1]); w.y = pk2(h[2], h[3]);
            *(u32x2*)(H + (size_t)r * DM + c) = w;
            if (FIRST) {
#pragma unroll
                for (int e = 0; e < 8; ++e) { const f32x4 w4 = *(const LAS f32x4*)(WG + e * DM + c); gp[e] += (h[0] * w4[0] + h[1] * w4[1]) + (h[2] * w4[2] + h[3] * w4[3]); }
            }
        }
        if (FIRST) {
#pragma unroll
            for (int e = 0; e < 8; ++e) gp[e] = wave_sum(gp[e]);
            if (lane < 4) { const float bi = a.in[13][lane], bf = a.in[13][4 + lane];
                float ig = 0.f, fg = 0.f;
#pragma unroll
                for (int e = 0; e < 4; ++e) { if (lane == e) { ig = gp[e]; fg = gp[4 + e]; } }
                ig += bi; fg += bf;
                const float lf = fminf(fg, 0.f) - log1pf(__expf(-fabsf(fg)));
                ((float*)(ws + WS_IG))[(size_t)r * 4 + lane] = ig; ((float*)(ws + WS_LF))[(size_t)r * 4 + lane] = lf; }
        }
        } }
    }
}
__device__ __forceinline__ float bfv(bf16 v) { return __uint_as_float((unsigned)v << 16); }
template <int MASK> __device__ __forceinline__ void phase3(const Args& a, LAS unsigned char* lds, int tid, int wave, int lane, int vcu, int G) {
    unsigned char* ws = a.ws;
    const bf16* P1 = (const bf16*)(ws + WS_P1); const bf16* PT = (const bf16*)(ws + WS_PT);
    const float* IG = (const float*)(ws + WS_IG); const float* LF = (const float*)(ws + WS_LF);
    const int i16 = lane & 15, g = lane >> 4;
    const int gw = vcu * NWAVES + wave, NGW = G * NWAVES;
    const bool swap_ = G == 256 && (vcu & 1);
    for (int s_ = 0; s_ < 2; ++s_) {
    const bool do_iv = (s_ == 0) != swap_;
    if ((MASK & 1) && do_iv) {
        bf16* ATT = (bf16*)(ws + WS_ATT);
        LAS float* ST = (LAS float*)lds;
        struct SState { float m, l; f32x4 o; };
#define SA_UPD(S, sc, mult, v4) do { const float mn_ = fmaxf((S).m, (sc)); const float fo_ = __expf((S).m - mn_), pn_ = (mult) * __expf((sc) - mn_); \
            (S).l = (S).l * fo_ + pn_; (S).o = (S).o * fo_ + (v4) * pn_; (S).m = mn_; } while (0)
#define SA_DOT(qv, kv4, out) do { float d_ = ((qv)[0] * (kv4)[0] + (qv)[1] * (kv4)[1]) + ((qv)[2] * (kv4)[2] + (qv)[3] * (kv4)[3]); \
            d_ += __builtin_bit_cast(float, __builtin_amdgcn_update_dpp(0, __builtin_bit_cast(int, d_), 0xB1, 0xF, 0xF, true)); \
            d_ += __builtin_bit_cast(float, __builtin_amdgcn_update_dpp(0, __builtin_bit_cast(int, d_), 0x4E, 0xF, 0xF, true)); \
            d_ += __builtin_bit_cast(float, __builtin_amdgcn_update_dpp(0, __builtin_bit_cast(int, d_), 0x141, 0xF, 0xF, true)); \
            d_ += __builtin_bit_cast(float, __builtin_amdgcn_update_dpp(0, __builtin_bit_cast(int, d_), 0x140, 0xF, 0xF, true)); (out) = d_; } while (0)
        for (int u = vcu; u < 256; u += G) {
            const int b = u >> 1, h = (u & 1) * 4 + g;
            const float* ck = a.in[2] + ((size_t)b * 2048 + 2048) * 512 + h * 64 + 4 * i16;
            const float* cv = a.in[3] + ((size_t)b * 2048 + 2048) * 512 + h * 64 + 4 * i16;
            const float* kn = a.out + O_KS + (size_t)b * 8 * 512 + h * 64 + 4 * i16;
            const float* vn = a.out + O_VS + (size_t)b * 8 * 512 + h * 64 + 4 * i16;
            f32x4 q[8];
#pragma unroll
            for (int t = 0; t < 8; ++t) { const u32x2 qw = *(const u32x2*)(P1 + (size_t)(NP + b * 8 + t) * P1W + C_AQ + h * 64 + 4 * i16); q[t] = (f32x4){bf_lo(qw.x), bf_hi(qw.x), bf_lo(qw.y), bf_hi(qw.y)}; }
            f32x4 qown = q[0];
#pragma unroll
            for (int t = 1; t < 8; ++t) if (wave == t) qown = q[t];
            const int r4 = wave & 3;
            SState sF, sM0, sM1, sN[8];
            sF.m = -1e30f; sF.l = 0.f; sF.o = (f32x4){0.f, 0.f, 0.f, 0.f}; sM0 = sF; sM1 = sF;
#pragma unroll
            for (int t = 0; t < 8; ++t) sN[t] = sF;
            for (int j0 = 33; j0 < 129; j0 += 8) {
                f32x4 kv[8], vv[8];
#pragma unroll
                for (int x = 0; x < 8; ++x) { const long p = wave - 16 * (j0 + x); kv[x] = __builtin_nontemporal_load((const f32x4*)(ck + p * 512)); vv[x] = __builtin_nontemporal_load((const f32x4*)(cv + p * 512)); }
#pragma unroll
                for (int x = 0; x < 8; ++x) { float sc; SA_DOT(qown, kv[x], sc); SA_UPD(sF, sc, 1.f, vv[x]); }
            }
            {
                f32x4 qa = q[0], qb = q[4];
#pragma unroll
                for (int t = 1; t < 4; ++t) if (r4 == t) { qa = q[t]; qb = q[t + 4]; }
                const int ibase = 33 + 48 * (wave >> 2);
                for (int i0 = 0; i0 < 48; i0 += 8) {
                    f32x4 kv[8], vv[8];
#pragma unroll
                    for (int x = 0; x < 8; ++x) { const long p = r4 - 4 * (ibase + i0 + x); kv[x] = __builtin_nontemporal_load((const f32x4*)(ck + p * 512)); vv[x] = __builtin_nontemporal_load((const f32x4*)(cv + p * 512)); }
#pragma unroll
                    for (int x = 0; x < 8; ++x) {
                        const int da = 4 * (ibase + i0 + x), db = da + 4;
                        const float ma = (da <= 512 ? 1.f : 0.f) + ((da & 15) == 0 ? 1.f : 0.f), mb = (db <= 512 ? 1.f : 0.f) + ((db & 15) == 0 ? 1.f : 0.f);
                        float sa, sb; SA_DOT(qa, kv[x], sa); SA_DOT(qb, kv[x], sb);
                        if (ma > 0.f) SA_UPD(sM0, sa, ma, vv[x]);
                        if (mb > 0.f) SA_UPD(sM1, sb, mb, vv[x]);
                    }
                }
            }
            for (int i0 = 0; i0 < 20; i0 += 4) {
                f32x4 kv[4], vv[4];
#pragma unroll
                for (int x = 0; x < 4; ++x) { int i = i0 + x; i = i < 17 ? i : 16; const long p = -128 + 17 * wave + i;
                    kv[x] = *(const f32x4*)(p < 0 ? ck + p * 512 : kn + p * 512); vv[x] = *(const f32x4*)(p < 0 ? cv + p * 512 : vn + p * 512); }
#pragma unroll
                for (int x = 0; x < 4; ++x) {
                    const int i = i0 + x; const bool rowok = i < 17; const int p = -128 + 17 * wave + (rowok ? i : 16);
#pragma unroll
                    for (int t = 0; t < 8; ++t) {
                        const int dist = t - p;
                        const float mult = rowok && dist >= 0 ? ((dist <= 128 ? 1.f : 0.f) + (((dist & 3) == 0 && dist <= 512) ? 1.f : 0.f) + (((dist & 15) == 0) ? 1.f : 0.f)) : 0.f;
                        if (mult > 0.f) { float sc; SA_DOT(q[t], kv[x], sc); SA_UPD(sN[t], sc, mult, vv[x]); }
                    }
                }
            }
            if (wave < 4) { const float mn = fmaxf(sM0.m, sF.m), f0 = __expf(sM0.m - mn), f1 = __expf(sF.m - mn); sM0.l = sM0.l * f0 + sF.l * f1; sM0.o = sM0.o * f0 + sF.o * f1; sM0.m = mn; }
            else          { const float mn = fmaxf(sM1.m, sF.m), f0 = __expf(sM1.m - mn), f1 = __expf(sF.m - mn); sM1.l = sM1.l * f0 + sF.l * f1; sM1.o = sM1.o * f0 + sF.o * f1; sM1.m = mn; }
            __syncthreads();
            {
                LAS float* mine = ST + (size_t)wave * (10 * 384) + lane * 6;
#define SA_PUT(slot, S) do { LAS float* p_ = mine + (slot) * 384; p_[0] = (S).m; p_[1] = (S).l; p_[2] = (S).o[0]; p_[3] = (S).o[1]; p_[4] = (S).o[2]; p_[5] = (S).o[3]; } while (0)
                SA_PUT(0, sM0); SA_PUT(1, sM1);
#pragma unroll
                for (int t = 0; t < 8; ++t) SA_PUT(2 + t, sN[t]);
            }
            __syncthreads();
            {
                const int t = wave;
                SState acc; acc.m = -1e30f; acc.l = 0.f; acc.o = (f32x4){0.f, 0.f, 0.f, 0.f};
#pragma unroll
                for (int k = 0; k < 10; ++k) {
                    const int srcw = k < 8 ? k : (t & 3) + 4 * (k - 8), slot = k < 8 ? 2 + t : (t < 4 ? 0 : 1);
                    const LAS float* p_ = ST + (size_t)srcw * (10 * 384) + slot * 384 + lane * 6;
                    const float m2 = p_[0], l2 = p_[1]; const f32x4 o2 = {p_[2], p_[3], p_[4], p_[5]};
                    const float mn = fmaxf(acc.m, m2), f0 = __expf(acc.m - mn), f1 = __expf(m2 - mn);
                    acc.l = acc.l * f0 + l2 * f1; acc.o = acc.o * f0 + o2 * f1; acc.m = mn;
                }
                const float inv = 1.f / acc.l; const float o0 = acc.o[0] * inv, o1 = acc.o[1] * inv, o2 = acc.o[2] * inv, o3 = acc.o[3] * inv;
                float sq = (o0 * o0 + o1 * o1) + (o2 * o2 + o3 * o3); sq += __shfl_xor(sq, 1); sq += __shfl_xor(sq, 2); sq += __shfl_xor(sq, 4); sq += __shfl_xor(sq, 8);
                u32x2 w; w.x = pk2(o0, o1); w.y = pk2(o2, o3); *(u32x2*)(ATT + (size_t)(NP + b * 8 + t) * 512 + h * 64 + 4 * i16) = w;
                if (i16 == 0) ((float*)(ws + WS_SSA))[(size_t)(NP + b * 8 + t) * 8 + h] = sq;
            }
        }
        __syncthreads();
    }
    if ((MASK & 2) && !do_iv) {
        LAS float* wl = (LAS float*)lds; LAS unsigned char* LK = lds + 1024;
        float* BS = (float*)(ws + WS_BS); float* CMB = (float*)(ws + WS_CMB); float* CH = (float*)(ws + WS_CH);
        float* DC = (float*)(ws + WS_DC); float* DN = (float*)(ws + WS_DN);
        for (int u = vcu; u < 512; u += G) {
            const int c = u >> 2, hd = u & 3;
            __syncthreads();
            for (int x = tid; x < 128 * 16; x += NTHREADS) { const int row = x >> 4, ch = x & 15;
                *(LAS u32x4*)(LK + row * 272 + 16 * ch) = *(const u32x4*)(P1 + ((size_t)128 * c + row) * P1W + C_MK + hd * 128 + 8 * ch); }
            if (wave == 0) {
                const int t = 128 * c + 2 * lane;
                const float lf0 = LF[(size_t)t * 4 + hd], lf1 = LF[(size_t)(t + 1) * 4 + hd], ig0 = IG[(size_t)t * 4 + hd], ig1 = IG[(size_t)(t + 1) * 4 + hd];
                float S = lf0 + lf1;
#pragma unroll
                for (int o = 1; o < 64; o <<= 1) { const float n = __shfl_up(S, o); if (lane >= o) S += n; }
                const float F1 = S, F0 = S - lf1, b0 = ig0 - F0, b1 = ig1 - F1;
                float Mx = fmaxf(b0, b1);
#pragma unroll
                for (int o = 1; o < 64; o <<= 1) { const float n = __shfl_up(Mx, o); if (lane >= o) Mx = fmaxf(Mx, n); }
                float Mp = __shfl_up(Mx, 1); if (lane == 0) Mp = -INFINITY;
                const float cm0 = fmaxf(Mp, b0), cm1 = Mx;
                const float FL = __shfl(S, 63), cmL = __shfl(Mx, 63);
                BS[(size_t)t * 4 + hd] = b0; BS[(size_t)(t + 1) * 4 + hd] = b1; CMB[(size_t)t * 4 + hd] = cm0; CMB[(size_t)(t + 1) * 4 + hd] = cm1;
                if (lane == 0) { CH[c * 4 + hd] = FL; CH[1024 + c * 4 + hd] = cmL; }
                wl[2 * lane] = __expf(b0 - cmL); wl[2 * lane + 1] = __expf(b1 - cmL);
            }
            __syncthreads();
            f32x4 acc[8], accn[8];
#pragma unroll
            for (int n = 0; n < 8; ++n) { acc[n] = (f32x4){0.f, 0.f, 0.f, 0.f}; accn[n] = acc[n]; }
            const bf16* vt = PT + (size_t)(R_MVT + hd * 128 + 16 * wave + i16) * MT + 128 * c + 8 * g;
            const int q4 = i16 >> 2, p4 = i16 & 3;
#pragma unroll
            for (int ks = 0; ks < 4; ++ks) {
                const u32x4 aw = __builtin_bit_cast(u32x4, ldfrag(vt + 32 * ks));
                const f32x4 w0 = *(const LAS f32x4*)(wl + 32 * ks + 8 * g), w1 = *(const LAS f32x4*)(wl + 32 * ks + 8 * g + 4);
                u32x4 as, a1;
                as.x = pk2(bf_lo(aw.x) * w0[0], bf_hi(aw.x) * w0[1]); as.y = pk2(bf_lo(aw.y) * w0[2], bf_hi(aw.y) * w0[3]);
                as.z = pk2(bf_lo(aw.z) * w1[0], bf_hi(aw.z) * w1[1]); as.w = pk2(bf_lo(aw.w) * w1[2], bf_hi(aw.w) * w1[3]);
                a1.x = pk2(w0[0], w0[1]); a1.y = pk2(w0[2], w0[3]); a1.z = pk2(w1[0], w1[1]); a1.w = pk2(w1[2], w1[3]);
                const bf16x8 af = __builtin_bit_cast(bf16x8, as), af1 = __builtin_bit_cast(bf16x8, a1);
#pragma unroll
                for (int n = 0; n < 8; ++n) {
                    typedef short v4i16_t __attribute__((ext_vector_type(4)));
                    const v4i16_t lo = __builtin_amdgcn_ds_read_tr16_b64_v4i16((LAS v4i16_t*)(LK + (32 * ks + 8 * g + q4) * 272 + 32 * n + 8 * p4));
                    const v4i16_t hi = __builtin_amdgcn_ds_read_tr16_b64_v4i16((LAS v4i16_t*)(LK + (32 * ks + 8 * g + 4 + q4) * 272 + 32 * n + 8 * p4));
                    const bf16x8 bfr = {lo[0], lo[1], lo[2], lo[3], hi[0], hi[1], hi[2], hi[3]};
                    acc[n] = mfma16(af, bfr, acc[n]); if (wave == 0) accn[n] = mfma16(af1, bfr, accn[n]); }
            }
            float* dc = DC + (size_t)(c * 4 + hd) * 16384;
#pragma unroll
            for (int n = 0; n < 8; ++n)
#pragma unroll
                for (int e = 0; e < 4; ++e) dc[(16 * wave + 4 * g + e) * 128 + 16 * n + i16] = acc[n][e];
            if (wave == 0 && g == 0) {
#pragma unroll
                for (int n = 0; n < 8; ++n) DN[(size_t)(c * 4 + hd) * 128 + 16 * n + i16] = accn[n][0];
            }
        }
        __syncthreads();
    }
    if ((MASK & 4) && !do_iv) {
        LAS float* QS = (LAS float*)lds; LAS float* KS = QS + 1024; LAS float* VS = KS + 1024; LAS float* SC = VS + 1024;
        bf16* HM = (bf16*)(ws + WS_HM); float* SSM = (float*)(ws + WS_SSM); LAS float* HB = SC + 256;
        for (int ub = vcu; ub < 512; ub += G)
            { const int b = ub >> 2, hd = ub & 3;
                __syncthreads();
                for (int i = tid; i < 3072; i += NTHREADS) { const int which = i >> 10, t = (i >> 7) & 7, d = i & 127; const size_t R = NP + 8 * b + t;
                    QS[i] = which == 0 ? bfv(P1[R * P1W + C_MQ + hd * 128 + d]) : which == 1 ? bfv(P1[R * P1W + C_MK + hd * 128 + d]) : bfv(PT[(size_t)(R_MVT + hd * 128 + d) * MT + R]); }
                if (tid == 0) {
                    const float m0 = a.in[6][b * 4 + hd]; float F = 0.f, cm = m0; float bb[8];
#pragma unroll
                    for (int t = 0; t < 8; ++t) { const size_t R = NP + 8 * b + t; F += LF[R * 4 + hd]; bb[t] = IG[R * 4 + hd] - F; cm = fmaxf(cm, bb[t]);
                        SC[t] = F; SC[8 + t] = bb[t]; SC[16 + t] = cm; SC[24 + t] = __expf(m0 - cm); SC[32 + t] = F + cm; }
#pragma unroll
                    for (int s = 0; s < 8; ++s) SC[40 + s] = __expf(bb[s] - cm);
                    SC[48] = __expf(m0 - cm); SC[49] = F + cm;
                }
                __syncthreads();
                if (tid < 64) {
                    const int t = tid >> 3, s = tid & 7; float d = 0.f;
                    for (int k = 0; k < 128; k += 4) { const f32x4 qv = *(const LAS f32x4*)(QS + t * 128 + k), kv = *(const LAS f32x4*)(KS + s * 128 + k); d += (qv[0] * kv[0] + qv[1] * kv[1]) + (qv[2] * kv[2] + qv[3] * kv[3]); }
                    SC[64 + tid] = s <= t ? d * __expf(SC[8 + s] - SC[16 + t]) : 0.f;
                } else if (tid < 128) {
                    const int t = (tid - 64) >> 3, part = tid & 7; float d = 0.f;
                    for (int k = 0; k < 16; ++k) d += a.in[5][(size_t)(b * 4 + hd) * 128 + 16 * part + k] * QS[t * 128 + 16 * part + k];
                    d += __shfl_xor(d, 1); d += __shfl_xor(d, 2); d += __shfl_xor(d, 4);
                    if (part == 0) SC[128 + t] = d;
                }
                const int dv = tid >> 2, qt = tid & 3;
                const float* c0 = a.in[4] + ((size_t)(b * 4 + hd) * 128 + dv) * 128 + 32 * qt;
                f32x4 cr[8];
#pragma unroll
                for (int i = 0; i < 8; ++i) cr[i] = *(const f32x4*)(c0 + 4 * i);
                float cq[8];
#pragma unroll
                for (int t = 0; t < 8; ++t) { float d = 0.f;
#pragma unroll
                    for (int i = 0; i < 8; ++i) { const f32x4 qv = *(const LAS f32x4*)(QS + t * 128 + 32 * qt + 4 * i); d += (cr[i][0] * qv[0] + cr[i][1] * qv[1]) + (cr[i][2] * qv[2] + cr[i][3] * qv[3]); }
                    d += __shfl_xor(d, 1); d += __shfl_xor(d, 2); cq[t] = d; }
                __syncthreads();
                const float decay = SC[48];
#pragma unroll
                for (int i = 0; i < 8; ++i) cr[i] = cr[i] * decay;
#pragma unroll
                for (int s = 0; s < 8; ++s) { const float coef = SC[40 + s] * VS[s * 128 + dv];
#pragma unroll
                    for (int i = 0; i < 8; ++i) cr[i] = cr[i] + *(const LAS f32x4*)(KS + s * 128 + 32 * qt + 4 * i) * coef; }
                float* cdst = a.out + O_CS + ((size_t)(b * 4 + hd) * 128 + dv) * 128 + 32 * qt;
#pragma unroll
                for (int i = 0; i < 8; ++i) *(f32x4*)(cdst + 4 * i) = cr[i];
                if (tid < 128) { float nn = decay * a.in[5][(size_t)(b * 4 + hd) * 128 + tid];
#pragma unroll
                    for (int s = 0; s < 8; ++s) nn += SC[40 + s] * KS[s * 128 + tid];
                    a.out[O_NS + (size_t)(b * 4 + hd) * 128 + tid] = nn; }
                if (tid == 0) a.out[O_MS + b * 4 + hd] = SC[49];
#pragma unroll
                for (int t = 0; t < 8; ++t) if ((t >> 1) == qt) {
                    float num = SC[24 + t] * cq[t], den = SC[24 + t] * SC[128 + t];
#pragma unroll
                    for (int s = 0; s < 8; ++s) { const float w = SC[64 + t * 8 + s]; num += w * VS[s * 128 + dv]; den += w; }
                    const float hh = num / fmaxf(fabsf(den), __expf(-SC[32 + t]));
                    const size_t R = NP + 8 * b + t;
                    const float hv = hh * sigmoidf_(bfv(P1[R * P1W + C_MO + hd * 128 + dv]));
                    HM[R * 512 + hd * 128 + dv] = (bf16)f2bf(hv); HB[t * 128 + dv] = hv;
                }
                __syncthreads();
                if (tid < 64) { const int t = tid >> 3, part = tid & 7; float sq = 0.f;
                    for (int k = 0; k < 16; ++k) { const float v = HB[t * 128 + 16 * part + k]; sq += v * v; }
                    sq += __shfl_xor(sq, 1); sq += __shfl_xor(sq, 2); sq += __shfl_xor(sq, 4);
                    if (part == 0) SSM[(size_t)(NP + 8 * b + t) * 4 + hd] = sq; }
            }
        __syncthreads();
    }
    if ((MASK & 8) && !do_iv) {
        const bf16* AVT = PT + (size_t)R_AVT * MT; bf16* VT4 = (bf16*)(ws + WS_VT4); bf16* VT16 = (bf16*)(ws + WS_VT16);
        for (int it = gw; it < 512 * 16; it += NGW) {
            const int f = it >> 4, t0 = (it & 15) * 1024;
            const bf16* src = AVT + (size_t)f * MT + t0 + 16 * lane;
            const u32x4 w0 = *(const u32x4*)src, w1 = *(const u32x4*)(src + 8);
            unsigned e[16];
            e[0] = w0.x & 0xffffu; e[1] = w0.x >> 16; e[2] = w0.y & 0xffffu; e[3] = w0.y >> 16; e[4] = w0.z & 0xffffu; e[5] = w0.z >> 16; e[6] = w0.w & 0xffffu; e[7] = w0.w >> 16;
            e[8] = w1.x & 0xffffu; e[9] = w1.x >> 16; e[10] = w1.y & 0xffffu; e[11] = w1.y >> 16; e[12] = w1.z & 0xffffu; e[13] = w1.z >> 16; e[14] = w1.w & 0xffffu; e[15] = w1.w >> 16;
            bf16* d16 = VT16 + (size_t)f * 16384 + (t0 >> 4) + lane;
#pragma unroll
            for (int r = 0; r < 16; ++r) d16[r * 1024] = (bf16)e[r];
#pragma unroll
            for (int r = 0; r < 4; ++r) { u32x2 o; o.x = e[r] | (e[4 + r] << 16); o.y = e[8 + r] | (e[12 + r] << 16);
                *(u32x2*)(VT4 + (size_t)f * 16384 + r * 4096 + (t0 >> 2) + 4 * lane) = o; }
        }
    }
    }
}
template <int BR>
__device__ __forceinline__ void pattn_group(const bf16* P1, const bf16* VTB, LAS float* O, LAS float* Mx, LAS float* Ls, int t0, int h, int gi, int i16, int g) {
    constexpr int dil = BR == 0 ? 1 : (BR == 1 ? 4 : 16);
    int r, ql0, mq0;
    if (BR == 0) { r = 0; ql0 = 16 * gi; mq0 = t0 + 16 * gi; }
    else if (BR == 1) { r = gi & 3; ql0 = 64 * (gi >> 2) + r; mq0 = (t0 >> 2) + 16 * (gi >> 2); }
    else { r = gi; ql0 = r; mq0 = t0 >> 4; }
    const bf16* qrow = P1 + (size_t)((mq0 + i16) * dil + r) * P1W + C_AQ + h * 64 + 8 * g;
    const bf16x8 qf0 = ldfrag(qrow), qf1 = ldfrag(qrow + 32);
    f32x4 s[5][2];
#pragma unroll
    for (int kb = 0; kb < 5; ++kb)
#pragma unroll
        for (int hf = 0; hf < 2; ++hf) {
            int mk = mq0 - 144 + 32 * kb + 8 * (i16 >> 2) + (i16 & 3) + 4 * hf; mk = mk < 0 ? 0 : mk;
            const bf16* krow = P1 + (size_t)(mk * dil + r) * P1W + C_AK + h * 64 + 8 * g;
            f32x4 acc = {0.f, 0.f, 0.f, 0.f};
            acc = mfma16(ldfrag(krow), qf0, acc); acc = mfma16(ldfrag(krow + 32), qf1, acc);
            s[kb][hf] = acc;
        }
    float mx = -1e30f;
#pragma unroll
    for (int kb = 0; kb < 5; ++kb)
#pragma unroll
        for (int hf = 0; hf < 2; ++hf)
#pragma unroll
            for (int e = 0; e < 4; ++e) {
                const int c = -144 + 32 * kb + 8 * g + 4 * hf + e, dist = i16 - c;
                const bool ok = dist >= 0 && dist <= 128 && (mq0 + c) >= 0;
                const float v = ok ? s[kb][hf][e] : -1e30f; s[kb][hf][e] = v; mx = fmaxf(mx, v);
            }
    mx = fmaxf(mx, __shfl_xor(mx, 16)); mx = fmaxf(mx, __shfl_xor(mx, 32));
    float l = 0.f;
#pragma unroll
    for (int kb = 0; kb < 5; ++kb)
#pragma unroll
        for (int hf = 0; hf < 2; ++hf)
#pragma unroll
            for (int e = 0; e < 4; ++e) { const float v = s[kb][hf][e]; const float p = v > -1e29f ? __expf(v - mx) : 0.f; s[kb][hf][e] = p; l += p; }
    l += __shfl_xor(l, 16); l += __shfl_xor(l, 32);
    f32x4 ot[4];
#pragma unroll
    for (int dt = 0; dt < 4; ++dt) ot[dt] = (f32x4){0.f, 0.f, 0.f, 0.f};
#pragma unroll
    for (int kb = 0; kb < 5; ++kb) {
        const bf16x8 pf = pack8(s[kb][0], s[kb][1]);
        int m0 = mq0 - 144 + 32 * kb + 8 * g; m0 = m0 < 0 ? 0 : m0;
#pragma unroll
        for (int dt = 0; dt < 4; ++dt) {
            const int f = h * 64 + 16 * dt + i16;
            const bf16* vrow = BR == 0 ? VTB + (size_t)f * MT + m0 : (BR == 1 ? VTB + (size_t)f * 16384 + r * 4096 + m0 : VTB + (size_t)f * 16384 + r * 1024 + m0);
            ot[dt] = mfma16(ldfrag(vrow), pf, ot[dt]);
        }
    }
    const int ql = ql0 + dil * i16;
    LAS float* orow = O + ql * 68 + 4 * g;
    if (BR == 0) {
#pragma unroll
        for (int dt = 0; dt < 4; ++dt) *(LAS f32x4*)(orow + 16 * dt) = ot[dt];
        if (g == 0) { Mx[ql] = mx; Ls[ql] = l; }
    } else {
        const float Mo = Mx[ql], Lo = Ls[ql], Mn = fmaxf(Mo, mx), fo = __expf(Mo - Mn), fn = __expf(mx - Mn);
#pragma unroll
        for (int dt = 0; dt < 4; ++dt) { const f32x4 v = *(const LAS f32x4*)(orow + 16 * dt); *(LAS f32x4*)(orow + 16 * dt) = v * fo + ot[dt] * fn; }
        if (g == 0) { Mx[ql] = Mn; Ls[ql] = Lo * fo + l * fn; }
    }
}
template <int BR>
__device__ __forceinline__ void pattn_pair(const bf16* P1, const bf16* VTB, LAS float* O, LAS float* Mx, LAS float* Ls, int t0, int h, int pi, int i16, int g) {
    constexpr int dil = BR == 0 ? 1 : 4;
    int r, ql0, mq0;
    if (BR == 0) { r = 0; ql0 = 32 * pi; mq0 = t0 + 32 * pi; }
    else { r = pi & 3; ql0 = 128 * (pi >> 2) + r; mq0 = (t0 >> 2) + 32 * (pi >> 2); }
    bf16x8 qf[2][2];
#pragma unroll
    for (int qt = 0; qt < 2; ++qt) { const bf16* qrow = P1 + (size_t)((mq0 + 16 * qt + i16) * dil + r) * P1W + C_AQ + h * 64 + 8 * g; qf[qt][0] = ldfrag(qrow); qf[qt][1] = ldfrag(qrow + 32); }
    float mrun[2] = {-1e30f, -1e30f}, lrun[2] = {0.f, 0.f};
    f32x4 ot[2][4];
#pragma unroll
    for (int qt = 0; qt < 2; ++qt)
#pragma unroll
        for (int dt = 0; dt < 4; ++dt) ot[qt][dt] = (f32x4){0.f, 0.f, 0.f, 0.f};
    bf16x8 kf[2][2][2], vf[2][4];
#define PP_LOAD(set, kb) do { _Pragma("unroll") for (int hf_ = 0; hf_ < 2; ++hf_) { int mk_ = mq0 - 128 + 32 * (kb) + 8 * (i16 >> 2) + (i16 & 3) + 4 * hf_; mk_ = mk_ < 0 ? 0 : mk_; \
            const bf16* krow_ = P1 + (size_t)(mk_ * dil + r) * P1W + C_AK + h * 64 + 8 * g; kf[set][hf_][0] = ldfrag(krow_); kf[set][hf_][1] = ldfrag(krow_ + 32); } \
        int m0_ = mq0 - 128 + 32 * (kb) + 8 * g; m0_ = m0_ < 0 ? 0 : m0_; \
        _Pragma("unroll") for (int dt_ = 0; dt_ < 4; ++dt_) { const int f_ = h * 64 + 16 * dt_ + i16; vf[set][dt_] = ldfrag(BR == 0 ? VTB + (size_t)f_ * MT + m0_ : VTB + (size_t)f_ * 16384 + r * 4096 + m0_); } } while (0)
#define PP_BLOCK(set, kb) do { f32x4 s[2][2]; \
        _Pragma("unroll") for (int hf = 0; hf < 2; ++hf) _Pragma("unroll") for (int qt = 0; qt < 2; ++qt) { f32x4 acc = {0.f, 0.f, 0.f, 0.f}; \
            acc = mfma16(kf[set][hf][0], qf[qt][0], acc); acc = mfma16(kf[set][hf][1], qf[qt][1], acc); s[hf][qt] = acc; } \
        _Pragma("unroll") for (int qt = 0; qt < 2; ++qt) { float mx = -1e30f; \
            _Pragma("unroll") for (int hf = 0; hf < 2; ++hf) _Pragma("unroll") for (int e = 0; e < 4; ++e) { const int c = -128 + 32 * (kb) + 8 * g + 4 * hf + e, dist = 16 * qt + i16 - c; \
                const bool ok = dist >= 0 && dist <= 128 && (mq0 + c) >= 0; const float v = ok ? s[hf][qt][e] : -1e30f; s[hf][qt][e] = v; mx = fmaxf(mx, v); } \
            mx = fmaxf(mx, __shfl_xor(mx, 16)); mx = fmaxf(mx, __shfl_xor(mx, 32)); \
            const float mn = fmaxf(mrun[qt], mx), fo = __expf(mrun[qt] - mn); float l = 0.f; \
            _Pragma("unroll") for (int hf = 0; hf < 2; ++hf) _Pragma("unroll") for (int e = 0; e < 4; ++e) { const float v = s[hf][qt][e]; const float p = v > -1e29f ? __expf(v - mn) : 0.f; s[hf][qt][e] = p; l += p; } \
            lrun[qt] = lrun[qt] * fo + l; mrun[qt] = mn; const bf16x8 pf = pack8(s[0][qt], s[1][qt]); \
            _Pragma("unroll") for (int dt = 0; dt < 4; ++dt) { ot[qt][dt] = ot[qt][dt] * fo; ot[qt][dt] = mfma16(vf[set][dt], pf, ot[qt][dt]); } } } while (0)
    PP_LOAD(0, 0);
#pragma unroll 1
    for (int kb = 0; kb < 4; kb += 2) {
        PP_LOAD(1, kb + 1); PP_BLOCK(0, kb); __builtin_amdgcn_sched_barrier(0);
        PP_LOAD(0, kb + 2); PP_BLOCK(1, kb + 1); __builtin_amdgcn_sched_barrier(0);
    }
    PP_BLOCK(0, 4);
#undef PP_BLOCK
#undef PP_LOAD
#pragma unroll
    for (int qt = 0; qt < 2; ++qt) {
        float l = lrun[qt]; l += __shfl_xor(l, 16); l += __shfl_xor(l, 32);
        const float mx = mrun[qt];
        const int ql = ql0 + dil * (16 * qt + i16);
        LAS float* orow = O + ql * 68 + 4 * g;
        if (BR == 0) {
#pragma unroll
            for (int dt = 0; dt < 4; ++dt) *(LAS f32x4*)(orow + 16 * dt) = ot[qt][dt];
            if (g == 0) { Mx[ql] = mx; Ls[ql] = l; }
        } else {
            const float Mo = Mx[ql], Lo = Ls[ql], Mn = fmaxf(Mo, mx), fo = __expf(Mo - Mn), fn = __expf(mx - Mn);
#pragma unroll
            for (int dt = 0; dt < 4; ++dt) { const f32x4 v = *(const LAS f32x4*)(orow + 16 * dt); *(LAS f32x4*)(orow + 16 * dt) = v * fo + ot[qt][dt] * fn; }
            if (g == 0) { Mx[ql] = Mn; Ls[ql] = Lo * fo + l * fn; }
        }
    }
}
__device__ __forceinline__ void phase4(const Args& a, LAS unsigned char* lds, int tid, int wave, int lane, int vcu, int G) {
    unsigned char* ws = a.ws;
    const bf16* P1 = (const bf16*)(ws + WS_P1); const bf16* PT = (const bf16*)(ws + WS_PT);
    const bf16* VT4 = (const bf16*)(ws + WS_VT4); const bf16* VT16 = (const bf16*)(ws + WS_VT16);
    bf16* ATT = (bf16*)(ws + WS_ATT);
    const int i16 = lane & 15, g = lane >> 4;
    LAS float* O = (LAS float*)lds; LAS float* Mx = O + 256 * 68; LAS float* Ls = Mx + 256;
    for (int u = vcu; u < 256 + 512; u += G) {
        if (u < 256) {
            LAS float* DEC = (LAS float*)lds; LAS float* SCL = DEC + 128;
            const float* CH = (const float*)(ws + WS_CH); float* MPREV = (float*)(ws + WS_CH) + 2048;
            const int hd = u >> 6;
            __syncthreads();
            if (wave == 0) {
                const int c0 = 2 * lane; const float b0 = CH[c0 * 4 + hd], a0 = b0 + CH[1024 + c0 * 4 + hd], b1 = CH[(c0 + 1) * 4 + hd], a1 = b1 + CH[1024 + (c0 + 1) * 4 + hd];
                float pa = fmaxf(a1, b1 + a0), pb = b0 + b1;
#pragma unroll
                for (int o = 1; o < 64; o <<= 1) { const float qa = __shfl_up(pa, o), qb = __shfl_up(pb, o); if (lane >= o) { pa = fmaxf(pa, pb + qa); pb = pb + qb; } }
                const float mend = fmaxf(pa, pb);
                float mprev0 = __shfl_up(mend, 1); if (lane == 0) mprev0 = 0.f;
                const float mmid = fmaxf(a0, b0 + mprev0);
                DEC[c0] = __expf(b0 + mprev0 - mmid); SCL[c0] = __expf(a0 - mmid); DEC[c0 + 1] = __expf(b1 + mmid - mend); SCL[c0 + 1] = __expf(a1 - mend);
                if ((u & 63) == 0) { MPREV[c0 * 4 + hd] = mprev0; MPREV[(c0 + 1) * 4 + hd] = mmid; if (lane == 63) a.out[O_MP + hd] = mend; }
            }
            __syncthreads();
            const float* DC = (const float*)(ws + WS_DC); bf16* CPREV = (bf16*)(ws + WS_CPREV);
            {
                const int seg = tid >> 7, el = tid & 127; const size_t e0 = (size_t)u * 256 + 2 * el;
                LAS float* CAR = SCL + 128;
                LAS f32x2* LL = (LAS f32x2*)(lds + 8192) + tid;
                f32x2 C = {0.f, 0.f}; float P = 1.f;
#pragma unroll 1
                for (int hb = 0; hb < 2; ++hb) {
                    f32x2 d[16];
#pragma unroll
                    for (int x = 0; x < 16; ++x) d[x] = *(const f32x2*)(DC + (size_t)(32 * seg + 16 * hb + x) * 65536 + e0);
#pragma unroll
                    for (int x = 0; x < 16; ++x) { const int c = 32 * seg + 16 * hb + x; C = C * DEC[c] + d[x] * SCL[c]; P *= DEC[c]; LL[(16 * hb + x) * 512] = C; }
                }
                CAR[(seg * 128 + el) * 3] = C[0]; CAR[(seg * 128 + el) * 3 + 1] = C[1]; CAR[(seg * 128 + el) * 3 + 2] = P;
                __syncthreads();
                f32x2 carry = {0.f, 0.f};
                for (int s2 = 0; s2 < seg; ++s2) { const LAS float* cp = CAR + (s2 * 128 + el) * 3; carry[0] = cp[0] + cp[2] * carry[0]; carry[1] = cp[1] + cp[2] * carry[1]; }
                f32x2 prev = carry; float qd = 1.f;
#pragma unroll 8
                for (int x = 0; x < 32; ++x) { const int c = 32 * seg + x; *(unsigned*)(CPREV + (size_t)c * 65536 + e0) = pk2(prev[0], prev[1]); qd *= DEC[c]; prev = LL[x * 512] + carry * qd; }
                if (seg == 3) *(f32x2*)(a.out + O_CP + e0) = prev;
            }
            if ((u & 63) == 0 && tid < 128) { const int dk = tid;
                const float* DN = (const float*)(ws + WS_DN); float* NPREV = (float*)(ws + WS_NPREV); float n = 0.f;
                for (int c0 = 0; c0 < 128; c0 += 16) { float dn[16];
#pragma unroll
                    for (int x = 0; x < 16; ++x) dn[x] = DN[(size_t)((c0 + x) * 4 + hd) * 128 + dk];
#pragma unroll
                    for (int x = 0; x < 16; ++x) { NPREV[(size_t)((c0 + x) * 4 + hd) * 128 + dk] = n; n = n * DEC[c0 + x] + dn[x] * SCL[c0 + x]; } }
                a.out[O_NP + hd * 128 + dk] = n;
            }
            __syncthreads();
            continue;
        }
        const int au = u - 256; const int h = G == 256 ? (au & 255) >> 5 : au & 7, pb = G == 256 ? 32 * (au >> 8) + (au & 31) : au >> 3, t0 = 256 * pb;
        __syncthreads();
        pattn_pair<0>(P1, PT + (size_t)R_AVT * MT, O, Mx, Ls, t0, h, wave, i16, g);
        __syncthreads();
        pattn_pair<1>(P1, VT4, O, Mx, Ls, t0, h, wave, i16, g);
        __syncthreads();
#pragma unroll
        for (int gg = 0; gg < 2; ++gg) pattn_group<2>(P1, VT16, O, Mx, Ls, t0, h, wave + 8 * gg, i16, g);
        __syncthreads();
        {
            const int ql = tid >> 1, hf = tid & 1; const float inv = 1.f / Ls[ql];
            const LAS float* orow = O + ql * 68 + 32 * hf;
            bf16* dst = ATT + (size_t)(t0 + ql) * 512 + h * 64 + 32 * hf;
            float sq = 0.f;
#pragma unroll
            for (int i = 0; i < 4; ++i) { const f32x4 x = *(const LAS f32x4*)(orow + 8 * i) * inv, y = *(const LAS f32x4*)(orow + 8 * i + 4) * inv; *(u32x4*)(dst + 8 * i) = __builtin_bit_cast(u32x4, pack8(x, y));
                sq += (x[0] * x[0] + x[1] * x[1]) + (x[2] * x[2] + x[3] * x[3]) + (y[0] * y[0] + y[1] * y[1]) + (y[2] * y[2] + y[3] * y[3]); }
            sq += __shfl_xor(sq, 1);
            if (hf == 0) ((float*)(ws + WS_SSA))[(size_t)(t0 + ql) * 8 + h] = sq;
        }
    }
    __syncthreads();
}
__device__ __forceinline__ void phase5(const Args& a, LAS unsigned char* lds, int tid, int wave, int lane, int vcu, int G, int pmode) {
    unsigned char* ws = a.ws;
    const bf16* P1 = (const bf16*)(ws + WS_P1); const bf16* PT = (const bf16*)(ws + WS_PT); const bf16* CPREV = (const bf16*)(ws + WS_CPREV);
    const float* NPREV = (const float*)(ws + WS_NPREV); const float* MPREV = (const float*)(ws + WS_CH) + 2048;
    const float* BS = (const float*)(ws + WS_BS); const float* CMB = (const float*)(ws + WS_CMB); const float* IG = (const float*)(ws + WS_IG);
    bf16* HM = pmode ? (bf16*)(ws + WS_QP) : (bf16*)(ws + WS_HM); float* SSM = pmode ? (float*)(ws + WS_QP + 32 * MiB) : (float*)(ws + WS_SSM);
    const int i16 = lane & 15, g = lane >> 4;
    LAS unsigned char* LK = lds; LAS unsigned char* LV = lds + 34816; LAS unsigned char* LC = lds + 69632;
    LAS float* LB = (LAS float*)(lds + 104448);
    for (int u = vcu; u < 512; u += G) {
        const int c = u >> 2, hd = u & 3, tg = wave, tl = 16 * tg + i16; const size_t t = (size_t)128 * c + tl;
        __syncthreads();
        if (!(pmode & 2)) for (int x = tid; x < 3 * 128 * 16; x += NTHREADS) {
            const int mat = x >> 11, row = (x >> 4) & 127, ch = x & 15;
            const bf16* src = mat == 0 ? P1 + ((size_t)128 * c + row) * P1W + C_MK + hd * 128 + 8 * ch
                            : mat == 1 ? PT + (size_t)(R_MVT + hd * 128 + row) * MT + 128 * c + 8 * ch
                                       : CPREV + ((size_t)(c * 4 + hd) * 128 + row) * 128 + 8 * ch;
            *(LAS u32x4*)(lds + mat * 34816 + row * 272 + 16 * ch) = *(const u32x4*)src;
        }
        if (tid < 128) LB[tid] = BS[((size_t)128 * c + tid) * 4 + hd];
        const float mprev = MPREV[c * 4 + hd], bmax = fmaxf(mprev, CMB[t * 4 + hd]), aint = __expf(mprev - bmax), m_t = (IG[t * 4 + hd] - BS[t * 4 + hd]) + bmax;
        bf16x8 qf[4];
#pragma unroll
        for (int ks = 0; ks < 4; ++ks) qf[ks] = ldfrag(P1 + t * P1W + C_MQ + hd * 128 + 32 * ks + 8 * g);
        u32x2 mo[8];
#pragma unroll
        for (int d = 0; d < 8; ++d) mo[d] = *(const u32x2*)(P1 + t * P1W + C_MO + hd * 128 + 16 * d + 4 * g);
        __syncthreads();
        f32x4 an[8], ac[8];
#pragma unroll
        for (int d = 0; d < 8; ++d) { an[d] = (f32x4){0.f, 0.f, 0.f, 0.f}; ac[d] = an[d]; }
        float nq = 0.f;
#pragma unroll 2
        for (int ks = 0; ks < ((pmode & 4) ? 0 : 4); ++ks) {
#pragma unroll
            for (int d = 0; d < 8; ++d) ac[d] = mfma16(*(const LAS bf16x8*)(LC + (16 * d + i16) * 272 + 64 * ks + 16 * g), qf[ks], ac[d]);
            const u32x4 qw = __builtin_bit_cast(u32x4, qf[ks]); const float* np = NPREV + (size_t)(c * 4 + hd) * 128 + 32 * ks + 8 * g;
            const f32x4 n0 = *(const f32x4*)np, n1 = *(const f32x4*)(np + 4);
            nq += (bf_lo(qw.x) * n0[0] + bf_hi(qw.x) * n0[1]) + (bf_lo(qw.y) * n0[2] + bf_hi(qw.y) * n0[3]) + (bf_lo(qw.z) * n1[0] + bf_hi(qw.z) * n1[1]) + (bf_lo(qw.w) * n1[2] + bf_hi(qw.w) * n1[3]);
        }
        float dsum = 0.f;
        const int nkb = (pmode & 4) ? 0 : (tg >> 1) + 1;
        for (int kb = 0; kb < nkb; ++kb) {
            f32x4 p[2];
#pragma unroll
            for (int hf = 0; hf < 2; ++hf) {
                const int s = 32 * kb + 8 * (i16 >> 2) + (i16 & 3) + 4 * hf;
                f32x4 acc = {0.f, 0.f, 0.f, 0.f};
#pragma unroll
                for (int ks = 0; ks < 4; ++ks) acc = mfma16(*(const LAS bf16x8*)(LK + s * 272 + 64 * ks + 16 * g), qf[ks], acc);
                const f32x4 b4 = *(const LAS f32x4*)(LB + 32 * kb + 8 * g + 4 * hf);
#pragma unroll
                for (int e = 0; e < 4; ++e) { const int sl = 32 * kb + 8 * g + 4 * hf + e; const float w = sl <= tl ? __expf(b4[e] - bmax) : 0.f; const float pv = acc[e] * w; p[hf][e] = pv; dsum += pv; }
            }
            const bf16x8 pf = pack8(p[0], p[1]);
#pragma unroll
            for (int d = 0; d < 8; ++d) an[d] = mfma16(*(const LAS bf16x8*)(LV + (16 * d + i16) * 272 + 64 * kb + 16 * g), pf, an[d]);
        }
        nq += __shfl_xor(nq, 16); nq += __shfl_xor(nq, 32);
        dsum += __shfl_xor(dsum, 16); dsum += __shfl_xor(dsum, 32);
        const float den = dsum + aint * nq, inv = 1.f / fmaxf(fabsf(den), __expf(-m_t));
        float ssq = 0.f;
        LAS unsigned char* LO = lds + 104960 + wave * (16 * 264);
#pragma unroll
        for (int d = 0; d < ((pmode & 8) ? 0 : 8); ++d) {
            const f32x4 hv = (an[d] + ac[d] * aint) * inv;
            float h0 = hv[0], h1 = hv[1], h2 = hv[2], h3 = hv[3];
            if (!(pmode & 16)) { h0 *= sigmoidf_(bf_lo(mo[d].x)); h1 *= sigmoidf_(bf_hi(mo[d].x)); h2 *= sigmoidf_(bf_lo(mo[d].y)); h3 *= sigmoidf_(bf_hi(mo[d].y)); }
            ssq += (h0 * h0 + h1 * h1) + (h2 * h2 + h3 * h3);
            u32x2 o; o.x = pk2(h0, h1); o.y = pk2(h2, h3); *(LAS u32x2*)(LO + i16 * 264 + (16 * d + 4 * g) * 2) = o;
        }
        if (!(pmode & 40)) {
#pragma unroll
            for (int j = 0; j < 4; ++j) { const int tk = (lane >> 4) + 4 * j, ch = lane & 15;
                const u32x2 lo2 = *(const LAS u32x2*)(LO + tk * 264 + 16 * ch), hi2 = *(const LAS u32x2*)(LO + tk * 264 + 16 * ch + 8);
                u32x4 w; w.x = lo2.x; w.y = lo2.y; w.z = hi2.x; w.w = hi2.y;
                *(u32x4*)(HM + ((size_t)128 * c + 16 * tg + tk) * 512 + hd * 128 + 8 * ch) = w; }
        }
        ssq += __shfl_xor(ssq, 16); ssq += __shfl_xor(ssq, 32);
        if (g == 0) SSM[t * 4 + hd] = ssq;
    }
    __syncthreads();
}
template <int MODE>
__device__ __forceinline__ void mini_gemm(const Args& a, LAS unsigned char* lds, int tid, int wave, int lane, int tile) {
    constexpr int NC = MODE == 0 ? 64 : 128, NTW = NC / 32;
    constexpr int BUFB = (64 + NC) * 272;
    unsigned char* ws = a.ws;
    const int i16 = lane & 15, g = lane >> 4, rt = wave & 3, ch = wave >> 2;
    const int rb = tile >> 4, cb = tile & 15;
    const size_t row0 = (size_t)NP + 64 * rb;
    const int col0 = cb * NC;
    const bf16* Asrc0 = MODE == 0 ? (const bf16*)(ws + WS_ATT) : (const bf16*)(ws + WS_H);
    const bf16* Asrc1 = MODE == 0 ? (const bf16*)(ws + WS_HM) : (const bf16*)(ws + WS_H);
    const bf16* Bsrc0 = MODE == 0 ? (const bf16*)(ws + WS_WOUT) : (const bf16*)(ws + WS_WPQ);
    const bf16* Bsrc1 = MODE == 0 ? (const bf16*)(ws + WS_WOUT) + (size_t)1024 * 512 : (const bf16*)(ws + WS_WPQ);
    constexpr int LDA = MODE == 0 ? 512 : 1024;
    constexpr int NCH = (64 + NC) * 16 / NTHREADS;
    u32x4 pre[NCH];
#define MG_FETCH(c) do { _Pragma("unroll") for (int x_ = 0; x_ < NCH; ++x_) { const int id_ = tid + x_ * NTHREADS, r_ = id_ >> 4, p_ = id_ & 15; \
        const int kof_ = MODE == 0 ? 128 * ((c) & 3) : 128 * (c); const bool hi_ = MODE == 0 && (c) >= 4; \
        const bf16* s_ = r_ < 64 ? (hi_ ? Asrc1 : Asrc0) + (row0 + r_) * LDA + kof_ + 8 * p_ : (hi_ ? Bsrc1 : Bsrc0) + (size_t)(col0 + r_ - 64) * LDA + kof_ + 8 * p_; \
        pre[x_] = *(const u32x4*)s_; } } while (0)
#define MG_STORE(buf) do { _Pragma("unroll") for (int x_ = 0; x_ < NCH; ++x_) { const int id_ = tid + x_ * NTHREADS, r_ = id_ >> 4, p_ = id_ & 15; \
        *(LAS u32x4*)(lds + (buf) * BUFB + r_ * 272 + 16 * p_) = pre[x_]; } } while (0)
    f32x4 acc[2][NTW];
#pragma unroll
    for (int h = 0; h < 2; ++h)
#pragma unroll
        for (int n = 0; n < NTW; ++n) acc[h][n] = (f32x4){0.f, 0.f, 0.f, 0.f};
    __syncthreads();
    MG_FETCH(0); MG_STORE(0);
    __syncthreads();
#pragma unroll 1
    for (int c = 0; c < 8; ++c) {
        if (c < 7) MG_FETCH(c + 1);
        const LAS unsigned char* B0 = lds + (c & 1) * BUFB;
        const int hsel = (MODE == 0 && c >= 4) ? 1 : 0;
#pragma unroll
        for (int ks = 0; ks < 4; ++ks) {
            const bf16x8 tf = *(const LAS bf16x8*)(B0 + (16 * rt + i16) * 272 + 64 * ks + 16 * g);
#pragma unroll
            for (int n = 0; n < NTW; ++n) {
                const bf16x8 wf = *(const LAS bf16x8*)(B0 + (64 + ch * (NC / 2) + 16 * n + i16) * 272 + 64 * ks + 16 * g);
                if (hsel) acc[1][n] = mfma16(wf, tf, acc[1][n]); else acc[0][n] = mfma16(wf, tf, acc[0][n]);
            }
        }
        if (c < 7) MG_STORE((c + 1) & 1);
        __syncthreads();
    }
#undef MG_FETCH
#undef MG_STORE
    const size_t r = row0 + 16 * rt + i16;
    if (MODE == 0) {
        const float* SSA = (const float*)(ws + WS_SSA) + r * 8; const float* SSM = (const float*)(ws + WS_SSM) + r * 4;
        const f32x4 s0 = *(const f32x4*)SSA, s1 = *(const f32x4*)(SSA + 4), s2 = *(const f32x4*)SSM;
        const float ra = 1.0f / sqrtf(((s0[0] + s0[1]) + (s0[2] + s0[3]) + (s1[0] + s1[1]) + (s1[2] + s1[3])) * (1.f / 512.f) + EPS);
        const float rm = 1.0f / sqrtf(((s2[0] + s2[1]) + (s2[2] + s2[3])) * (1.f / 512.f) + EPS);
        const int brow = 1 + (int)((r - NP) >> 3);
        const float* gt = (const float*)(ws + WS_MOD) + (size_t)brow * 6144 + 2048;
        const float* xrow = a.in[1] + (r - NP) * DM; float* x1 = (float*)(ws + WS_X1) + r * DM;
#pragma unroll
        for (int n = 0; n < NTW; ++n) { const int col = col0 + ch * (NC / 2) + 16 * n + 4 * g;
            *(f32x4*)(x1 + col) = *(const f32x4*)(xrow + col) + *(const f32x4*)(gt + col) * (acc[0][n] * ra + acc[1][n] * rm); }
    } else {
        bf16* QP = (bf16*)(ws + WS_QP) + r * 2048;
#pragma unroll
        for (int n = 0; n < NTW; ++n) { const int col = col0 + ch * (NC / 2) + 16 * n + 4 * g; const f32x4 v = acc[0][n];
            u32x2 o; o.x = pk2(v[0], v[1]); o.y = pk2(v[2], v[3]); *(u32x2*)(QP + col) = o; }
    }
    __syncthreads();
}
__device__ __forceinline__ int f2key(float f) { const int b = __float_as_int(f); return b ^ ((b >> 31) & 0x7fffffff); }
__device__ __forceinline__ float key2f(int k) { return __int_as_float(k ^ ((k >> 31) & 0x7fffffff)); }
template <int N> __device__ __forceinline__ void merge_desc(int (&k)[N]) {
#pragma unroll
    for (int st = N >> 1; st > 0; st >>= 1)
#pragma unroll
        for (int i = 0; i < N; ++i) { const int j = i ^ st; if (j > i) { const int hi = max(k[i], k[j]), lo = min(k[i], k[j]); k[i] = hi; k[j] = lo; } }
}
template <int N> __device__ __forceinline__ void sort_desc(int (&k)[N]) {
#pragma unroll
    for (int sz = 2; sz <= N; sz <<= 1)
#pragma unroll
        for (int st = sz >> 1; st > 0; st >>= 1)
#pragma unroll
            for (int i = 0; i < N; ++i) { const int j = i ^ st; if (j > i) { const bool desc = (i & sz) == 0 || sz == N; const int hi = max(k[i], k[j]), lo = min(k[i], k[j]); k[i] = desc ? hi : lo; k[j] = desc ? lo : hi; } }
}
template <int N> __device__ __forceinline__ void merge_desc_p(int (&k)[N], int (&p)[N]) {
#pragma unroll
    for (int st = N >> 1; st > 0; st >>= 1)
#pragma unroll
        for (int i = 0; i < N; ++i) { const int j = i ^ st; if (j > i) { const bool sw = k[j] > k[i]; const int ki = sw ? k[j] : k[i], kj = sw ? k[i] : k[j], pi = sw ? p[j] : p[i], pj = sw ? p[i] : p[j]; k[i] = ki; k[j] = kj; p[i] = pi; p[j] = pj; } }
}
template <int N> __device__ __forceinline__ void sort_desc_p(int (&k)[N], int (&p)[N]) {
#pragma unroll
    for (int sz = 2; sz <= N; sz <<= 1)
#pragma unroll
        for (int st = sz >> 1; st > 0; st >>= 1)
#pragma unroll
            for (int i = 0; i < N; ++i) { const int j = i ^ st; if (j > i) { const bool desc = (i & sz) == 0 || sz == N; const bool sw = desc ? (k[j] > k[i]) : (k[j] < k[i]);
                const int ki = sw ? k[j] : k[i], kj = sw ? k[i] : k[j], pi = sw ? p[j] : p[i], pj = sw ? p[i] : p[j]; k[i] = ki; k[j] = kj; p[i] = pi; p[j] = pj; } }
}
__device__ __forceinline__ void side_top16(const LAS unsigned char* KL, const bf16x8 (&qf)[4], int side, int i16, int g, int (&top)[16]) {
    f32x4 acc[8];
#pragma unroll
    for (int n = 0; n < 8; ++n) acc[n] = (f32x4){0.f, 0.f, 0.f, 0.f};
    const LAS unsigned char* krow = KL + side * 34816 + i16 * 272 + 16 * g;
#pragma unroll
    for (int ks = 0; ks < 4; ++ks) {
#pragma unroll
        for (int n = 0; n < 8; ++n) acc[n] = mfma16(*(const LAS bf16x8*)(krow + n * (16 * 272) + 64 * ks), qf[ks], acc[n]); }
    int ka[16], kb[16];
#pragma unroll
    for (int n = 0; n < 4; ++n)
#pragma unroll
        for (int e = 0; e < 4; ++e) { ka[n * 4 + e] = (f2key(acc[n][e]) & ~127) | (16 * n + 4 * g + e); kb[n * 4 + e] = (f2key(acc[n + 4][e]) & ~127) | (16 * (n + 4) + 4 * g + e); }
    sort_desc<16>(ka); sort_desc<16>(kb);
#pragma unroll
    for (int i = 0; i < 16; ++i) top[i] = max(ka[i], kb[15 - i]);
    merge_desc<16>(top);
#pragma unroll
    for (int o = 16; o <= 32; o <<= 1) {
        int oth[16];
#pragma unroll
        for (int i = 0; i < 16; ++i) oth[i] = __shfl_xor(top[15 - i], o);
#pragma unroll
        for (int i = 0; i < 16; ++i) top[i] = max(top[i], oth[i]);
        merge_desc<16>(top);
    }
}
__host__ __device__ constexpr int cand_off(int i) { return i == 0 ? 0 : i == 1 ? 16 : i == 2 ? 24 : i == 3 ? 29 : i == 4 ? 33 : i == 5 ? 36 : i == 6 ? 38 : i == 7 ? 40 : 42 + (i - 8); }
__host__ __device__ constexpr int cand_cnt(int i) { return 16 / (i + 1); }
__device__ __forceinline__ float gelu_erf(float x) { return 0.5f * x * (1.f + erff(x * 0.70710678118654752f)); }
__device__ __forceinline__ void phase9(const Args& a, LAS unsigned char* lds, int tid, int wave, int lane, int vcu, int G) {
    unsigned char* ws = a.ws;
    const bf16* KEYS = (const bf16*)(ws + WS_KEYS); const bf16* QP = (const bf16*)(ws + WS_QP); const bf16* U16 = (const bf16*)(ws + WS_U); const bf16* V16 = (const bf16*)(ws + WS_V);
    const float* X1 = (const float*)(ws + WS_X1); const float* mod = (const float*)(ws + WS_MOD);
    int* SEL_E = (int*)(ws + WS_SELE); float* SEL_G = (float*)(ws + WS_SELG);
    const int i16 = lane & 15, g = lane >> 4;
    LAS unsigned char* KL = lds + 16384;
    int hprev = -1;
    for (int u = vcu; u < 8 * (MT / 128); u += G) {
        const int h = u & 7; const size_t T0 = (size_t)(u >> 3) * 128 + 16 * wave;
        bf16x8 qa[4], qb[4];
        { const bf16* qrow = QP + (T0 + i16) * 2048 + h * 256 + 8 * g;
#pragma unroll
          for (int ks = 0; ks < 4; ++ks) { qa[ks] = ldfrag(qrow + 32 * ks); qb[ks] = ldfrag(qrow + 128 + 32 * ks); } }
        if (h != hprev) {
            __syncthreads();
            for (int c = tid; c < 2 * 128 * 16; c += NTHREADS) { const int row = c >> 4, ch = c & 15;
                *(LAS u32x4*)(KL + (row >> 7) * 34816 + (row & 127) * 272 + 16 * ch) = *(const u32x4*)(KEYS + ((size_t)h * 256 + row) * 128 + 8 * ch); }
            __syncthreads();
            hprev = h;
        }
        {
            int va[16], vb[16];
            side_top16(KL, qa, 0, i16, g, va); __builtin_amdgcn_sched_barrier(0);
            side_top16(KL, qb, 1, i16, g, vb); __builtin_amdgcn_sched_barrier(0);
#define CAND_GROUP(dst, lo_) do { _Pragma("unroll") for (int x_ = 0; x_ < 16; ++x_) dst[x_] = (int)0x80000000; \
            _Pragma("unroll") for (int i = 0; i < 16; ++i) _Pragma("unroll") for (int j = 0; j < 16; ++j) if (j < cand_cnt(i) && cand_off(i) + j >= (lo_) && cand_off(i) + j < (lo_) + 16) \
                dst[(cand_off(i) + j) & 15] = (f2key(key2f(va[i] & ~127) + key2f(vb[j] & ~127)) & ~255) | (i * 16 + j); } while (0)
            int k0[16];
            { int c1[16], c2[16], c3[16];
              CAND_GROUP(k0, 0); CAND_GROUP(c1, 16); CAND_GROUP(c2, 32); CAND_GROUP(c3, 48);
#pragma unroll
              for (int i = 0; i < 16; ++i) k0[i] = g == 0 ? k0[i] : g == 1 ? c1[i] : g == 2 ? c2[i] : c3[i]; }
            __builtin_amdgcn_sched_barrier(0);
            sort_desc<16>(k0); __builtin_amdgcn_sched_barrier(0);
#pragma unroll
            for (int o = 16; o <= 32; o <<= 1) {
                int oth[16];
#pragma unroll
                for (int i = 0; i < 16; ++i) oth[i] = __shfl_xor(k0[15 - i], o);
#pragma unroll
                for (int i = 0; i < 16; ++i) k0[i] = max(k0[i], oth[i]);
                merge_desc<16>(k0); __builtin_amdgcn_sched_barrier(0);
            }
            int p0[16];
            {
                LAS unsigned char* LK = lds + tid * 32;
                u32x4 wa, wb;
#pragma unroll
                for (int q = 0; q < 4; ++q) { wa[q] = (va[4 * q] & 127) | ((va[4 * q + 1] & 127) << 8) | ((va[4 * q + 2] & 127) << 16) | ((va[4 * q + 3] & 127) << 24);
                                              wb[q] = (vb[4 * q] & 127) | ((vb[4 * q + 1] & 127) << 8) | ((vb[4 * q + 2] & 127) << 16) | ((vb[4 * q + 3] & 127) << 24); }
                *(LAS u32x4*)LK = wa; *(LAS u32x4*)(LK + 16) = wb;
#pragma unroll
                for (int r = 0; r < 16; ++r) { const int ci = (k0[r] >> 4) & 15, cj = k0[r] & 15; p0[r] = ((int)LK[ci] << 7) | (int)LK[16 + cj]; }
            }
            const float mx = key2f(k0[0] & ~255); float ex[16], sum = 0.f;
#pragma unroll
            for (int i = 0; i < 16; ++i) { ex[i] = __expf(key2f(k0[i] & ~255) - mx); sum += ex[i]; }
            const float inv = 1.f / sum;
            if (g == 0) {
#pragma unroll
                for (int i = 0; i < 16; ++i) { SEL_E[(T0 + i16) * 128 + h * 16 + i] = p0[i]; SEL_G[(T0 + i16) * 128 + h * 16 + i] = ex[i] * inv; }
            }
        }
    }
    if (G == 256) { if (vcu >= 64) prep_tables(a, lane, (vcu - 64) * NWAVES + wave, 192 * NWAVES, 2048, 8192); }
    else prep_tables(a, lane, vcu * NWAVES + wave, G * NWAVES, 2048, 8192);
}
#define NRANGE 8
#define GTK 3
#define NB 4
__device__ __forceinline__ float b2f(unsigned w, int b) { return (float)(int)(signed char)(w >> (8 * b)); }
__device__ __forceinline__ int dpp_isum63(int v) {
    v += __builtin_amdgcn_update_dpp(0, v, 0xB1, 0xF, 0xF, true);
    v += __builtin_amdgcn_update_dpp(0, v, 0x4E, 0xF, 0xF, true);
    v += __builtin_amdgcn_update_dpp(0, v, 0x141, 0xF, 0xF, true);
    v += __builtin_amdgcn_update_dpp(0, v, 0x140, 0xF, 0xF, true);
    v += __builtin_amdgcn_update_dpp(0, v, 0x142, 0xA, 0xF, false);
    v += __builtin_amdgcn_update_dpp(0, v, 0x143, 0xC, 0xF, false);
    return __builtin_amdgcn_readlane(v, 63);
}
__device__ __forceinline__ float gelu_as(float v) {
    const float av = fabsf(v), t = __builtin_amdgcn_rcpf(av * 0.2316418882f + 1.0f);
    float q = t * 0.5307027145f + (-0.7265760135f); q = q * t + 0.7107068705f; q = q * t + (-0.142248368f); q = q * t + 0.127414796f; q = q * t;
    const float e = __builtin_amdgcn_exp2f((v * v) * (-0.72134752044f)), m = v * (q * e);
    return v < 0.f ? m : v - m;
}
struct PickBuf { u32x4 uq[NB], vq[NB]; float gt, su, sv; };
#define P10_LOAD(buf, tk, k0) do { int ev_[NB]; \
        _Pragma("unroll") for (int x_ = 0; x_ < NB; ++x_) ev_[x_] = (int)PE[(tk) * 128 + (k0) + x_]; \
        { const int em_ = (int)PE[(tk) * 128 + (k0) + (lane & 3)] & emask; buf.gt = PG[(tk) * 128 + (k0) + (lane & 3)]; buf.su = SCU[em_]; buf.sv = SCV[em_]; } \
        _Pragma("unroll") for (int x_ = 0; x_ < NB; ++x_) { const int e_ = __builtin_amdgcn_readfirstlane(ev_[x_]) & emask; \
            buf.uq[x_] = *(const u32x4*)(U8 + (size_t)e_ * DM + 16 * lane); buf.vq[x_] = *(const u32x4*)(V8 + (size_t)e_ * DM + 16 * lane); } } while (0)
#define DPPI(v, ctrl) __builtin_amdgcn_update_dpp(0, (v), (ctrl), 0xF, 0xF, true)
#ifdef PROBE_VALU
#define P10_EXTRA(va_, tk) { const float cz_ = cf_ * zero_; y[tk][4 * e_] += cz_ * b2f(va_, 0); y[tk][4 * e_ + 1] += cz_ * b2f(va_, 1); y[tk][4 * e_ + 2] += cz_ * b2f(va_, 2); y[tk][4 * e_ + 3] += cz_ * b2f(va_, 3); }
#else
#define P10_EXTRA(va_, tk)
#endif
#define P10_COMP(buf, tk) do { int a_[NB]; \
        _Pragma("unroll") for (int x_ = 0; x_ < NB; ++x_) { a_[x_] = 0; \
            _Pragma("unroll") for (int e_ = 0; e_ < 4; ++e_) { const unsigned ha_ = hq[tk][e_], ua_ = buf.uq[x_][e_]; a_[x_] = __builtin_amdgcn_sdot4((int)ha_, (int)ua_, a_[x_], false); } } \
        const bool b0_ = (lane & 1) != 0, b1_ = (lane & 2) != 0; \
        const int r01_ = (b0_ ? a_[1] : a_[0]) + DPPI(b0_ ? a_[0] : a_[1], 0xB1), r23_ = (b0_ ? a_[3] : a_[2]) + DPPI(b0_ ? a_[2] : a_[3], 0xB1); \
        int r_ = (b1_ ? r23_ : r01_) + DPPI(b1_ ? r01_ : r23_, 0x4E); \
        r_ += DPPI(r_, 0x124); r_ += DPPI(r_, 0x128); r_ += __shfl_xor(r_, 16); r_ += __shfl_xor(r_, 32); \
        const float cfv_ = buf.gt * gelu_as((float)r_ * (sh[tk] * buf.su)) * buf.sv; \
        _Pragma("unroll") for (int x_ = 0; x_ < NB; ++x_) { const float cf_ = __builtin_bit_cast(float, __builtin_amdgcn_readlane(__builtin_bit_cast(int, cfv_), x_)); \
            _Pragma("unroll") for (int e_ = 0; e_ < 4; ++e_) { const unsigned va_ = buf.vq[x_][e_]; \
                y[tk][4 * e_] += cf_ * b2f(va_, 0); y[tk][4 * e_ + 1] += cf_ * b2f(va_, 1); y[tk][4 * e_ + 2] += cf_ * b2f(va_, 2); y[tk][4 * e_ + 3] += cf_ * b2f(va_, 3); P10_EXTRA(va_, tk) } } } while (0)
#define P10_LOADU(buf, tk, k0) do { int ev_[NB]; \
        _Pragma("unroll") for (int x_ = 0; x_ < NB; ++x_) ev_[x_] = (int)PE[(tk) * 128 + (k0) + x_]; \
        { const int em_ = (int)PE[(tk) * 128 + (k0) + (lane & 3)] & emask; buf.gt = PG[(tk) * 128 + (k0) + (lane & 3)]; buf.su = SCU[em_]; buf.sv = SCV[em_]; } \
        _Pragma("unroll") for (int x_ = 0; x_ < NB; ++x_) { const int e_ = __builtin_amdgcn_readfirstlane(ev_[x_]) & emask; \
            buf.uq[x_] = *(const u32x4*)(U8 + (size_t)e_ * DM + 16 * lane); } } while (0)
#define P10_COMPU(buf, tk, k0) do { int a_[NB]; \
        _Pragma("unroll") for (int x_ = 0; x_ < NB; ++x_) { a_[x_] = 0; \
            _Pragma("unroll") for (int e_ = 0; e_ < 4; ++e_) { const unsigned ha_ = hq[tk][e_], ua_ = buf.uq[x_][e_]; a_[x_] = __builtin_amdgcn_sdot4((int)ha_, (int)ua_, a_[x_], false); } } \
        const bool b0_ = (lane & 1) != 0, b1_ = (lane & 2) != 0; \
        const int r01_ = (b0_ ? a_[1] : a_[0]) + DPPI(b0_ ? a_[0] : a_[1], 0xB1), r23_ = (b0_ ? a_[3] : a_[2]) + DPPI(b0_ ? a_[2] : a_[3], 0xB1); \
        int r_ = (b1_ ? r23_ : r01_) + DPPI(b1_ ? r01_ : r23_, 0x4E); \
        r_ += DPPI(r_, 0x124); r_ += DPPI(r_, 0x128); r_ += __shfl_xor(r_, 16); r_ += __shfl_xor(r_, 32); \
        const float cfv_ = buf.gt * gelu_as((float)r_ * (sh[tk] * buf.su)) * buf.sv; \
        if (lane < 4) PG[(tk) * 128 + (k0) + lane] = cfv_; } while (0)
#define P10_LOADV(buf, tk, k0) do { int ev_[NB]; \
        _Pragma("unroll") for (int x_ = 0; x_ < NB; ++x_) ev_[x_] = (int)PE[(tk) * 128 + (k0) + x_]; \
        buf.gt = PG[(tk) * 128 + (k0) + (lane & 3)]; \
        _Pragma("unroll") for (int x_ = 0; x_ < NB; ++x_) { const int e_ = __builtin_amdgcn_readfirstlane(ev_[x_]) & emask; \
            buf.vq[x_] = *(const u32x4*)(V8 + (size_t)e_ * DM + 16 * lane); } } while (0)
#define P10_COMPV(buf, tk) do { \
        _Pragma("unroll") for (int x_ = 0; x_ < NB; ++x_) { const float cf_ = __builtin_bit_cast(float, __builtin_amdgcn_readlane(__builtin_bit_cast(int, buf.gt), x_)); \
            _Pragma("unroll") for (int e_ = 0; e_ < 4; ++e_) { const unsigned va_ = buf.vq[x_][e_]; \
                y[tk][4 * e_] += cf_ * b2f(va_, 0); y[tk][4 * e_ + 1] += cf_ * b2f(va_, 1); y[tk][4 * e_ + 2] += cf_ * b2f(va_, 2); y[tk][4 * e_ + 3] += cf_ * b2f(va_, 3); } } } while (0)
struct PickBuf2 { u32x4 q[4]; float gt, su, sv, cf[4]; int pd; };
#define P10_LOADU2(buf, tk, k0, h) do { \
        _Pragma("unroll") for (int x_ = 0; x_ < 4; ++x_) { const int e_ = (int)PE[(tk) * 128 + (k0) + 2 * x_ + hl] & emask; \
            buf.q[x_] = *(const u32x4*)(U8 + (size_t)e_ * DM + 512 * (h) + 16 * lq); } \
        if ((h) == 1) { const int pi_ = (tk) * 128 + (k0) + 2 * (lane & 3) + hl; const int em_ = (int)PE[pi_] & emask; buf.gt = PG[pi_]; buf.pd = PD[pi_]; buf.su = SCU[em_]; buf.sv = SCV[em_]; } } while (0)
#define P10_COMPU2(buf, tk, k0, h) do { int a_[4]; \
        _Pragma("unroll") for (int x_ = 0; x_ < 4; ++x_) { a_[x_] = 0; \
            _Pragma("unroll") for (int e_ = 0; e_ < 4; ++e_) { const unsigned ha_ = hqh[tk][h][e_], ua_ = buf.q[x_][e_]; a_[x_] = __builtin_amdgcn_sdot4((int)ha_, (int)ua_, a_[x_], false); } } \
        const bool b0_ = (lane & 1) != 0, b1_ = (lane & 2) != 0; \
        const int r01_ = (b0_ ? a_[1] : a_[0]) + DPPI(b0_ ? a_[0] : a_[1], 0xB1), r23_ = (b0_ ? a_[3] : a_[2]) + DPPI(b0_ ? a_[2] : a_[3], 0xB1); \
        int r_ = (b1_ ? r23_ : r01_) + DPPI(b1_ ? r01_ : r23_, 0x4E); \
        r_ += DPPI(r_, 0x124); r_ += DPPI(r_, 0x128); r_ += __shfl_xor(r_, 16); \
        const int pi_ = (tk) * 128 + (k0) + 2 * (lane & 3) + hl; \
        if ((h) == 0) { if ((lane & 28) == 0) PD[pi_] = r_; } \
        else { const float cfv_ = buf.gt * gelu_as((float)(r_ + buf.pd) * (sh[tk] * buf.su)) * buf.sv; if ((lane & 28) == 0) PG[pi_] = cfv_; } } while (0)
#define P10_LOADV2(buf, tk, k0, h) do { \
        _Pragma("unroll") for (int x_ = 0; x_ < 4; ++x_) { const int e_ = (int)PE[(tk) * 128 + (k0) + 2 * x_ + hl] & emask; buf.cf[x_] = PG[(tk) * 128 + (k0) + 2 * x_ + hl]; \
            buf.q[x_] = *(const u32x4*)(V8 + (size_t)e_ * DM + 512 * (h) + 16 * lq); } } while (0)
#define P10_COMPV2(buf, tk, Y) do { \
        _Pragma("unroll") for (int x_ = 0; x_ < 4; ++x_) { const float cf_ = buf.cf[x_]; \
            _Pragma("unroll") for (int e_ = 0; e_ < 4; ++e_) { const unsigned va_ = buf.q[x_][e_]; \
                Y[tk][4 * e_] += cf_ * b2f(va_, 0); Y[tk][4 * e_ + 1] += cf_ * b2f(va_, 1); Y[tk][4 * e_ + 2] += cf_ * b2f(va_, 2); Y[tk][4 * e_ + 3] += cf_ * b2f(va_, 3); } } } while (0)
#define P10_SWEEPU(h) do { PickBuf2 A, B, C; \
        P10_LOADU2(A, 0, 0, h); P10_LOADU2(B, 1, 0, h); P10_LOADU2(C, 2, 0, h); \
        for (int k = 0; k < 120; k += 8) { \
            SB_; P10_COMPU2(A, 0, k, h); SB_; P10_LOADU2(A, 0, k + 8, h); \
            SB_; P10_COMPU2(B, 1, k, h); SB_; P10_LOADU2(B, 1, k + 8, h); \
            SB_; P10_COMPU2(C, 2, k, h); SB_; P10_LOADU2(C, 2, k + 8, h); } \
        SB_; P10_COMPU2(A, 0, 120, h); SB_; P10_COMPU2(B, 1, 120, h); SB_; P10_COMPU2(C, 2, 120, h); SB_; } while (0)
#define P10_SWEEPV(h, Y) do { PickBuf2 A, B, C; \
        P10_LOADV2(A, 0, 0, h); P10_LOADV2(B, 1, 0, h); P10_LOADV2(C, 2, 0, h); \
        for (int k = 0; k < 120; k += 8) { \
            SB_; P10_COMPV2(A, 0, Y); SB_; P10_LOADV2(A, 0, k + 8, h); \
            SB_; P10_COMPV2(B, 1, Y); SB_; P10_LOADV2(B, 1, k + 8, h); \
            SB_; P10_COMPV2(C, 2, Y); SB_; P10_LOADV2(C, 2, k + 8, h); } \
        SB_; P10_COMPV2(A, 0, Y); SB_; P10_COMPV2(B, 1, Y); SB_; P10_COMPV2(C, 2, Y); SB_; } while (0)
__device__ __forceinline__ void phase10(const Args& a, LAS unsigned char* lds, int tid, int wave, int lane, int vcu, int G, int emask, bool probe) {
    unsigned char* ws = a.ws;
    const unsigned char* U8 = (const unsigned char*)(ws + WS_U); const unsigned char* V8 = (const unsigned char*)(ws + WS_V);
    const float* SCU = (const float*)(ws + WS_CH) + 65536; const float* SCV = (const float*)(ws + WS_CH) + 131072;
    const float* X1 = (const float*)(ws + WS_X1); const float* mod = (const float*)(ws + WS_MOD);
    const int* SEL_E = (const int*)(ws + WS_SELE); const float* SEL_G = (const float*)(ws + WS_SELG);
    const int gw = vcu * NWAVES + wave, NGW = G * NWAVES;
    LAS unsigned short* PE = (LAS unsigned short*)(lds + wave * 4096);
    LAS float* PG = (LAS float*)(lds + wave * 4096 + 1024);
    LAS int* PD = (LAS int*)(lds + wave * 4096 + 2560);
    LAS float* YS = (LAS float*)(lds + 32768 + wave * 6144);
    const int hl = lane >> 5, lq = lane & 31;
    const int c0 = 16 * lane;
#ifdef PROBE_VALU
    const float zero_ = (float)a.ph_lo;
#endif
    const int nrounds = G == 256 ? 3 : (MT + GTK * NGW - 1) / (GTK * NGW);
    for (int rd = 0; rd < nrounds; ++rd) {
        u32x4 hq[GTK]; float sh[GTK];
#pragma unroll
        for (int tk = 0; tk < GTK; ++tk) {
            const int slot = GTK * rd + tk;
            const size_t R = G == 256 ? ((slot < 8 || (slot == 8 && wave < 4)) ? (size_t)68 * vcu + (slot < 8 ? wave + 8 * slot : 64 + wave) : (size_t)MT) : (size_t)gw + (size_t)slot * NGW;
            hq[tk] = (u32x4){0u, 0u, 0u, 0u}; sh[tk] = 0.f;
            if (R < MT) {
                const int brow = R < NP ? 0 : 1 + (int)((R - NP) >> 3);
                const float* mrow = mod + (size_t)brow * 6144;
                float x1v[16];
#pragma unroll
                for (int q = 0; q < 4; ++q) { const f32x4 t4 = *(const f32x4*)(X1 + R * DM + c0 + 4 * q);
#pragma unroll
                    for (int e = 0; e < 4; ++e) x1v[4 * q + e] = t4[e]; }
                float ss = 0.f;
#pragma unroll
                for (int e = 0; e < 16; ++e) ss += x1v[e] * x1v[e];
                const float rstd = 1.0f / sqrtf(wave_sum(ss) * (1.f / DM) + EPS);
                float h2[16], am = 0.f;
#pragma unroll
                for (int e = 0; e < 16; ++e) { const int c = c0 + e; h2[e] = x1v[e] * rstd * a.in[16][c] * (1.f + mrow[4096 + c]) + mrow[3072 + c]; am = fmaxf(am, fabsf(h2[e])); }
#pragma unroll
                for (int o = 1; o < 64; o <<= 1) am = fmaxf(am, __shfl_xor(am, o));
                const float inv = am > 0.f ? 127.f / am : 0.f; sh[tk] = am * (1.f / 127.f);
#pragma unroll
                for (int q = 0; q < 4; ++q) { unsigned pk = 0;
#pragma unroll
                    for (int e = 0; e < 4; ++e) pk |= ((unsigned)(int)rintf(h2[4 * q + e] * inv) & 0xffu) << (8 * e);
                    hq[tk][q] = pk; }
                const int e0 = SEL_E[R * 128 + 2 * lane], e1 = SEL_E[R * 128 + 2 * lane + 1]; const float g0 = SEL_G[R * 128 + 2 * lane], g1 = SEL_G[R * 128 + 2 * lane + 1];
                const int r0 = e0 >> 11, r1 = e1 >> 11; int pos0 = 0, pos1 = 0, off = 0;
                const unsigned long long lt = (1ull << lane) - 1ull;
                for (int r = 0; r < NRANGE; ++r) {
                    const unsigned long long m0 = __ballot(r0 == r), m1 = __ballot(r1 == r);
                    if (r0 == r) pos0 = off + __popcll(m0 & lt);
                    if (r1 == r) pos1 = off + __popcll(m0) + __popcll(m1 & lt);
                    off += __popcll(m0) + __popcll(m1);
                }
                PE[tk * 128 + pos0] = (unsigned short)e0; PE[tk * 128 + pos1] = (unsigned short)e1; PG[tk * 128 + pos0] = g0; PG[tk * 128 + pos1] = g1;
            } else { PE[tk * 128 + 2 * lane] = 0; PE[tk * 128 + 2 * lane + 1] = 0; PG[tk * 128 + 2 * lane] = 0.f; PG[tk * 128 + 2 * lane + 1] = 0.f; }
        }
#define SB_ __builtin_amdgcn_sched_barrier(0)
        u32x4 hqh[GTK][2];
#pragma unroll
        for (int tk = 0; tk < GTK; ++tk)
#pragma unroll
            for (int h = 0; h < 2; ++h)
#pragma unroll
                for (int e = 0; e < 4; ++e) hqh[tk][h][e] = (unsigned)__shfl((int)hq[tk][e], 32 * h + lq);
        P10_SWEEPU(0); P10_SWEEPU(1);
        float y[GTK][16];
#pragma unroll
        for (int tk = 0; tk < GTK; ++tk)
#pragma unroll
            for (int e = 0; e < 16; ++e) y[tk][e] = 0.f;
        P10_SWEEPV(0, y);
#pragma unroll
        for (int tk = 0; tk < GTK; ++tk) {
#pragma unroll
            for (int q = 0; q < 4; ++q) { f32x4 s4;
#pragma unroll
                for (int e = 0; e < 4; ++e) { s4[e] = y[tk][4 * q + e] + __shfl_xor(y[tk][4 * q + e], 32); y[tk][4 * q + e] = 0.f; }
                if (hl == 0) *(LAS f32x4*)(YS + (tk * 32 + lq) * 16 + 4 * q) = s4; } }
        P10_SWEEPV(1, y);
#pragma unroll
        for (int tk = 0; tk < GTK; ++tk) {
#pragma unroll
            for (int q = 0; q < 4; ++q) { const f32x4 s4 = *(const LAS f32x4*)(YS + (tk * 32 + lq) * 16 + 4 * q);
#pragma unroll
                for (int e = 0; e < 4; ++e) { const float s1 = y[tk][4 * q + e] + __shfl_xor(y[tk][4 * q + e], 32); y[tk][4 * q + e] = hl ? s1 : s4[e]; } } }
#pragma unroll
        for (int tk = 0; tk < GTK; ++tk) {
            const int slot = GTK * rd + tk;
            const size_t R = G == 256 ? ((slot < 8 || (slot == 8 && wave < 4)) ? (size_t)68 * vcu + (slot < 8 ? wave + 8 * slot : 64 + wave) : (size_t)MT) : (size_t)gw + (size_t)slot * NGW;
            if (R < MT) {
                const int brow = R < NP ? 0 : 1 + (int)((R - NP) >> 3);
                const float* mrow = mod + (size_t)brow * 6144;
                float xo[16]; float s2 = 0.f;
#pragma unroll
                for (int q = 0; q < 4; ++q) { const f32x4 t4 = *(const f32x4*)(X1 + R * DM + c0 + 4 * q), g4 = *(const f32x4*)(mrow + 5120 + c0 + 4 * q);
#pragma unroll
                    for (int e = 0; e < 4; ++e) { xo[4 * q + e] = t4[e] + g4[e] * y[tk][4 * q + e]; s2 += xo[4 * q + e] * xo[4 * q + e]; } }
                const float r2 = 1.0f / sqrtf(wave_sum(s2) * (1.f / DM) + EPS);
                float* dst = probe ? (float*)(ws + WS_QP) + R * DM : (R < NP ? a.out + O_YP + R * DM : a.out + O_YS + (R - NP) * DM);
#pragma unroll
                for (int q = 0; q < 4; ++q) { const f32x4 gf = *(const f32x4*)(a.in[22] + c0 + 4 * q); f32x4 o;
#pragma unroll
                    for (int e = 0; e < 4; ++e) o[e] = xo[4 * q + e] * r2 * gf[e];
                    *(f32x4*)(dst + c0 + 4 * q) = o; }
            }
        }
    }
}
__global__ void __launch_bounds__(NTHREADS, 2) hymba_fwd(Args args) {
    extern __shared__ __attribute__((aligned(16))) unsigned char lds_raw[];
    LAS unsigned char* lds = (LAS unsigned char*)lds_raw;
    const int tid = threadIdx.x, lane = tid & 63, wave = __builtin_amdgcn_readfirstlane(tid >> 6);
    const int G = gridDim.x; const int bx = blockIdx.x; const int vcu = (G % 8 == 0) ? (bx % 8) * (G / 8) + bx / 8 : bx;
    for (int u = tid; u < (LDS_BYTES - LDSCTL_OFF) / 4; u += NTHREADS) ((LAS unsigned*)(lds + LDSCTL_OFF))[u] = 0u;
    __syncthreads();
    const int lo = args.ph_lo, hi = args.ph_hi;
    XcdBarrier bar; bar.bar = (unsigned*)(args.ws + WS_CTL) + CW_BAR; bar.x = 0; bar.st = nullptr;
    if (hi - lo > 1) bar = xcd_barrier_post((unsigned*)(args.ws + WS_CTL) + CW_BAR, (volatile LAS unsigned*)(lds + LDSCTL_OFF + 64));
#ifdef ONLY_PHASE
#define IN(k) ((k) == ONLY_PHASE)
#else
#define IN(k) (lo <= (k) && (k) < hi)
#endif
#define SEAM(k) do { if (IN(k) && IN((k) + 1)) xcd_barrier(bar); } while (0)
#ifndef PROBE_PHASE
#define PROBE_PHASE -1
#endif
#define NREP(k) ((k) == PROBE_PHASE ? 2 : 1)
#ifndef PROBE_P3MASK
#define PROBE_P3MASK 15
#endif
#ifndef PROBE_P5MODE
#define PROBE_P5MODE 0
#endif
#ifndef PROBE_P0MASK
#define PROBE_P0MASK 15
#endif
#ifndef PROBE_GMODE
#define PROBE_GMODE 0
#endif
    if (IN(0)) for (int rep_ = 0; rep_ < NREP(0); ++rep_) { if (rep_) xcd_barrier(bar); phase0(args, lds, tid, wave, lane, vcu, G, rep_ ? PROBE_P0MASK : 15); } SEAM(0);
    if (IN(1)) for (int rep_ = 0; rep_ < NREP(1); ++rep_) { if (rep_) xcd_barrier(bar); phase_norm<true>(args, lds, tid, wave, lane, vcu, G); } SEAM(1);
    if (IN(2)) for (int rep_ = 0; rep_ < NREP(2); ++rep_) { if (rep_) xcd_barrier(bar);
        unsigned char* ws = args.ws;
        { pg8::Gemm gm{(const pg8::bf16_t*)(ws + WS_H), (const pg8::bf16_t*)(ws + WS_WIN), MT, 2560, DM}; pg8::StaticOrder S; S.init(MT, 2560, G, bx);
          EpiStd E{(bf16*)(ws + WS_P1), (const float*)(ws + WS_ROPE), args.out + O_KP, args.out + O_KS};
          pg8::gemm_phase<EpiStd, pg8::StaticOrder, true, true>(lds, gm, S, E); }
        __syncthreads();
        { pg8::Gemm gm{(const pg8::bf16_t*)(ws + WS_WIN) + (size_t)2560 * DM, (const pg8::bf16_t*)(ws + WS_H), 1024, MT, DM}; pg8::StaticOrder S; S.init(1024, MT, G, (bx + 88) % G);
          EpiTr E{(bf16*)(ws + WS_PT), args.out + O_VP, args.out + O_VS};
          pg8::gemm_phase<EpiTr, pg8::StaticOrder, true, true>(lds, gm, S, E); }
        __syncthreads();
        if (rep_ == 0 && G == 256 && bx >= 184) { prep_weights_late(args, lds, wave, lane, (bx - 184) * NWAVES + wave, 72 * NWAVES);
            prep_tables(args, lane, (bx - 184) * NWAVES + wave, 72 * NWAVES, 0, 2048); }
        else if (rep_ == 0 && G != 256) { prep_weights_late(args, lds, wave, lane, bx * NWAVES + wave, G * NWAVES); prep_tables(args, lane, bx * NWAVES + wave, G * NWAVES, 0, 2048); }
        __syncthreads();
    } SEAM(2);
    if (IN(3)) for (int rep_ = 0; rep_ < NREP(3); ++rep_) { if (rep_) xcd_barrier(bar); if (rep_ == 0) phase3<15>(args, lds, tid, wave, lane, vcu, G); else phase3<PROBE_P3MASK>(args, lds, tid, wave, lane, vcu, G); } SEAM(3);
    if (IN(4)) for (int rep_ = 0; rep_ < NREP(4); ++rep_) { if (rep_) xcd_barrier(bar); phase4(args, lds, tid, wave, lane, vcu, G); } SEAM(4);
    if (IN(5)) for (int rep_ = 0; rep_ < NREP(5); ++rep_) { if (rep_) xcd_barrier(bar); phase5(args, lds, tid, wave, lane, vcu, G, rep_ ? PROBE_P5MODE : 0); } SEAM(5);
    if (IN(6)) for (int rep_ = 0; rep_ < NREP(6); ++rep_) { if (rep_) xcd_barrier(bar);
        unsigned char* ws = args.ws;
        { pg8::Gemm gm{(const pg8::bf16_t*)(ws + WS_ATT), (const pg8::bf16_t*)(ws + WS_WOUT), NP, DM, 512, (const pg8::bf16_t*)(ws + WS_HM), (const pg8::bf16_t*)(ws + WS_WOUT) + (size_t)1024 * 512};
          pg8::PairOrder S; S.S.init(NP, DM, G, bx);
          EpiX1P E{args.in[0], args.in[1], (const float*)(ws + WS_MOD), (const float*)(ws + WS_SSA), (const float*)(ws + WS_SSM), (float*)(ws + WS_X1)};
          pg8::gemm_phase<EpiX1P, pg8::PairOrder, true, true>(lds, gm, S, E); }
        __syncthreads();
        for (int t = vcu; t < 256; t += G) mini_gemm<0>(args, lds, tid, wave, lane, t);
    } SEAM(6);
    if (IN(7)) for (int rep_ = 0; rep_ < NREP(7); ++rep_) { if (rep_) xcd_barrier(bar); phase_norm<false>(args, lds, tid, wave, lane, vcu, G); } SEAM(7);
    if (IN(8)) for (int rep_ = 0; rep_ < NREP(8); ++rep_) { if (rep_) xcd_barrier(bar);
        unsigned char* ws = args.ws;
        pg8::Gemm gm{(const pg8::bf16_t*)(ws + WS_H), (const pg8::bf16_t*)(ws + WS_WPQ), NP, 2048, DM}; pg8::StaticOrder S; S.init(NP, 2048, G, bx);
        pg8::EpiBf16<0> E{(pg8::bf16_t*)(ws + WS_QP), 2048, nullptr, 0, 0, 1.f};
        pg8::gemm_phase<pg8::EpiBf16<0>, pg8::StaticOrder, true, true>(lds, gm, S, E);
        __syncthreads();
        for (int t = vcu; t < 256; t += G) mini_gemm<1>(args, lds, tid, wave, lane, t);
    } SEAM(8);
    if (IN(9)) for (int rep_ = 0; rep_ < NREP(9); ++rep_) { if (rep_) xcd_barrier(bar); phase9(args, lds, tid, wave, lane, vcu, G); } SEAM(9);
    if (IN(10)) for (int rep_ = 0; rep_ < NREP(10); ++rep_) { if (rep_) xcd_barrier(bar); phase10(args, lds, tid, wave, lane, vcu, G, (rep_ && PROBE_GMODE) ? PROBE_GMODE : 0x3fff, rep_ && PROBE_GMODE); }
#undef IN
#undef SEAM
}

extern "C" void kernel_launch(void* const* d_in, const int* in_sizes, int n_in, void* d_out, int out_size, void* d_ws, size_t ws_size, hipStream_t stream) {
    static int grid = 0;
    if (grid == 0) {
        if (n_in != 23 || out_size != (int)O_END || ws_size < WS_END) { fprintf(stderr, "kernel_launch: unexpected shapes (n_in %d, out %d, ws %zu); nothing launched\n", n_in, out_size, ws_size); grid = -1; return; }
        int dev = 0, cus = 0, per_cu = 0;
        if (hipGetDevice(&dev) != hipSuccess || hipDeviceGetAttribute(&cus, hipDeviceAttributeMultiprocessorCount, dev) != hipSuccess) { grid = -1; return; }
        if (hipFuncSetAttribute((const void*)hymba_fwd, hipFuncAttributeMaxDynamicSharedMemorySize, LDS_BYTES) != hipSuccess) { fprintf(stderr, "kernel_launch: hipFuncSetAttribute failed\n"); grid = -1; return; }
        if (hipOccupancyMaxActiveBlocksPerMultiprocessor(&per_cu, (const void*)hymba_fwd, NTHREADS, LDS_BYTES) != hipSuccess || per_cu < 1) { fprintf(stderr, "kernel_launch: occupancy query says %d blocks per CU\n", per_cu); }
        (void)hipGetLastError();
        grid = cus;
    }
    if (grid < 0) return;
    (void)hipMemsetAsync((char*)d_ws + WS_CTL, 0, CTL_ZERO_BYTES, stream);
    Args a{};
    for (int i = 0; i < 23; ++i) a.in[i] = (const float*)d_in[i];
    a.out = (float*)d_out; a.ws = (unsigned char*)d_ws;
#if MK_ONE_LAUNCH
    a.ph_lo = 0; a.ph_hi = NPH;
    hipLaunchKernelGGL(hymba_fwd, dim3(grid), dim3(NTHREADS), LDS_BYTES, stream, a);
#else
    for (int p = 0; p < NPH; ++p) { a.ph_lo = p; a.ph_hi = p + 1; hipLaunchKernelGGL(hymba_fwd, dim3(grid), dim3(NTHREADS), LDS_BYTES, stream, a); }
#endif
}
```
